# Optimizing an MI355X kernel written in HIP

```python
import math
import jax
import jax.numpy as jnp
from jax import lax
import numpy as np

D_MODEL = 1024
BATCH = 8
SEQ = 4096
DEPTH = 2

F32 = jnp.float32
EPS = 1e-6
D_MIX = 2 * D_MODEL
GROUP_WIDTH = D_MIX // 4
CONV_WIDTH = 4
CHUNK = 64
GDN_HEADS = 4
GDN_DK = 128
GDN_DV = GROUP_WIDTH // GDN_HEADS
HGRN_HEADS = 4
HGRN_DK = 128
HGRN_DV = GROUP_WIDTH // HGRN_HEADS
LRU_WIDTH = GROUP_WIDTH
LRU_BLOCKS = 4
LRU_BLOCK_W = LRU_WIDTH // LRU_BLOCKS
LRU_C = 8.0
GLA_HEADS = 4
GLA_DK = 64
GLA_DV = GROUP_WIDTH // GLA_HEADS
GLA_GATE_RANK = 16
GLA_GATE_TAU = 16.0
PEER_HEADS = 8
PEER_NKEYS = 128
PEER_EXPERTS = PEER_NKEYS * PEER_NKEYS
PEER_QDIM = 256
PEER_TOPK = 16
PEER_TOKEN_BLOCK = 128
IN_SIZES = (
    GDN_HEADS * GDN_DK, GDN_HEADS * GDN_DK, GDN_HEADS * GDN_DV, GDN_HEADS * GDN_DV, GDN_HEADS, GDN_HEADS,
    HGRN_HEADS * HGRN_DK, HGRN_HEADS * HGRN_DK, HGRN_HEADS * HGRN_DV, HGRN_HEADS * HGRN_DV,
    LRU_WIDTH, LRU_WIDTH,
    GLA_HEADS * GLA_DK, GLA_HEADS * GLA_DK, GLA_HEADS * GLA_DV, GLA_HEADS * GLA_DV, GLA_GATE_RANK,
)
D_IN = sum(IN_SIZES)

kernel_name = "hybrid_parallel_heads_peer_block"


def rmsnorm(x, w):
    xf = x.astype(F32)
    y = xf * lax.rsqrt(jnp.mean(xf * xf, axis=-1, keepdims=True) + EPS) * w.astype(F32)
    return y.astype(x.dtype)


def l2norm(t):
    return t * lax.rsqrt(jnp.sum(t * t, axis=-1, keepdims=True) + EPS)


def to_heads(t, n_heads):
    b, s, _ = t.shape
    return t.reshape(b, s, n_heads, -1).transpose(0, 2, 1, 3)


def causal_depthwise_conv(x, w):
    width, ch = w.shape
    return lax.conv_general_dilated(
        x, w[:, None, :].astype(x.dtype), window_strides=(1,), padding=[(width - 1, 0)],
        dimension_numbers=("NWC", "WIO", "NWC"), feature_group_count=ch)


def gated_head_rmsnorm(o, gate, w):
    b, h, s, d = o.shape
    o = o * lax.rsqrt(jnp.mean(o * o, axis=-1, keepdims=True) + EPS) * w.astype(F32)
    o = o.transpose(0, 2, 1, 3).reshape(b, s, h * d)
    return (o * jax.nn.silu(gate.astype(F32))).astype(gate.dtype)


def to_chunks(a):
    b, h, s = a.shape[:3]
    return jnp.moveaxis(a.reshape(b, h, s // CHUNK, CHUNK, *a.shape[3:]), 2, 0)


def from_chunks(o):
    n, b, h, c, d = o.shape
    return jnp.moveaxis(o, 0, 2).reshape(b, h, n * c, d)


def chunk_gated_delta_rule(q, k, v, g, beta):
    b, h, s, dk = q.shape
    dv = v.shape[-1]
    qc, kc, vc = to_chunks(q * dk ** -0.5), to_chunks(k), to_chunks(v)
    gc, bc = to_chunks(g), to_chunks(beta)
    gcum = jnp.cumsum(gc, axis=-1)
    causal = jnp.tril(jnp.ones((CHUNK, CHUNK), bool))
    strict = jnp.tril(jnp.ones((CHUNK, CHUNK), bool), -1)
    decay = jnp.exp(jnp.where(causal, gcum[..., :, None] - gcum[..., None, :], -jnp.inf))
    k_beta = kc * bc[..., None]
    a_low = jnp.where(strict, jnp.einsum("nbhid,nbhjd->nbhij", k_beta, kc) * decay, 0.0)
    lower = a_low + jnp.eye(CHUNK, dtype=F32)
    u = lax.linalg.triangular_solve(lower, vc * bc[..., None], left_side=True, lower=True)
    w = lax.linalg.triangular_solve(lower, k_beta * jnp.exp(gcum)[..., None], left_side=True, lower=True)
    attn_qk = jnp.einsum("nbhid,nbhjd->nbhij", qc, kc) * decay
    q_dec = qc * jnp.exp(gcum)[..., None]
    k_dec = kc * jnp.exp(gcum[..., -1:] - gcum)[..., None]
    g_last = jnp.exp(gcum[..., -1])

    def step(state, inp):
        u_i, w_i, a_i, qd_i, kd_i, gl_i = inp
        v_new = u_i - jnp.einsum("bhck,bhkv->bhcv", w_i, state)
        o_i = jnp.einsum("bhck,bhkv->bhcv", qd_i, state) + jnp.einsum("bhij,bhjv->bhiv", a_i, v_new)
        state = state * gl_i[..., None, None] + jnp.einsum("bhck,bhcv->bhkv", kd_i, v_new)
        return state, o_i

    s0 = jnp.zeros((b, h, dk, dv), F32)
    _, o = lax.scan(step, s0, (u, w, attn_qk, q_dec, k_dec, g_last))
    return from_chunks(o)


def chunk_gated_linear_attention(q, k, v, log_g, scale):
    b, h, s, dk = q.shape
    dv = v.shape[-1]
    qc, kc, vc = to_chunks(q * scale), to_chunks(k), to_chunks(v)
    bc = jnp.cumsum(to_chunks(log_g), axis=-2)
    causal = jnp.tril(jnp.ones((CHUNK, CHUNK), bool))[:, :, None]

    def step(state, inp):
        q_i, k_i, v_i, b_i = inp
        o_inter = jnp.einsum("bhck,bhkv->bhcv", q_i * jnp.exp(b_i), state)
        diff = jnp.where(causal, b_i[:, :, :, None, :] - b_i[:, :, None, :, :], -jnp.inf)
        attn = jnp.einsum("bhik,bhjk,bhijk->bhij", q_i, k_i, jnp.exp(diff))
        o_i = o_inter + jnp.einsum("bhij,bhjv->bhiv", attn, v_i)
        b_last = b_i[:, :, -1:, :]
        state = state * jnp.exp(b_last[:, :, 0, :, None]) + jnp.einsum(
            "bhck,bhcv->bhkv", k_i * jnp.exp(b_last - b_i), v_i)
        return state, o_i

    s0 = jnp.zeros((b, h, dk, dv), F32)
    _, o = lax.scan(step, s0, (qc, kc, vc, bc))
    return from_chunks(o)


def linear_recurrence_scan(a, x):
    def combine(c1, c2):
        a1, b1 = c1
        a2, b2 = c2
        return a1 * a2, a2 * b1 + b2
    _, h = lax.associative_scan(combine, (a, x), axis=1)
    return h


def gated_deltanet_group(q, k, v, z, a, bta, conv_w, a_log, dt_bias, norm_w):
    qkv = jax.nn.silu(causal_depthwise_conv(jnp.concatenate([q, k, v], axis=-1), conv_w))
    q, k, v = jnp.split(qkv, [GDN_HEADS * GDN_DK, 2 * GDN_HEADS * GDN_DK], axis=-1)
    qh = l2norm(to_heads(q, GDN_HEADS).astype(F32))
    kh = l2norm(to_heads(k, GDN_HEADS).astype(F32))
    vh = to_heads(v, GDN_HEADS).astype(F32)
    beta = jax.nn.sigmoid(bta.astype(F32)).transpose(0, 2, 1)
    g = -(jnp.exp(a_log.astype(F32)) * jax.nn.softplus(a.astype(F32) + dt_bias.astype(F32)))
    o = chunk_gated_delta_rule(qh, kh, vh, g.transpose(0, 2, 1), beta)
    return gated_head_rmsnorm(o, z, norm_w)


def hgrn2_group(q, f, i, g, lower_bound, norm_w):
    lb = lower_bound.astype(F32)
    fl = f.astype(F32)
    log_f = jnp.log(lb + (1.0 - lb) * jax.nn.sigmoid(fl))
    k = (1.0 - lb) * jax.nn.sigmoid(-fl)
    qh = to_heads(jax.nn.silu(q.astype(F32)), HGRN_HEADS)
    o = chunk_gated_linear_attention(qh, to_heads(k, HGRN_HEADS), to_heads(i.astype(F32), HGRN_HEADS),
                                     to_heads(log_f, HGRN_HEADS), HGRN_DK ** -0.5)
    return gated_head_rmsnorm(o, g, norm_w)


def rglru_group(xb, gate, conv_w, conv_b, w_a, b_a, w_x, b_x, lam):
    xb = causal_depthwise_conv(xb, conv_w) + conv_b.astype(xb.dtype)
    b, s, _ = xb.shape
    xblk = xb.reshape(b, s, LRU_BLOCKS, LRU_BLOCK_W)
    r = jax.nn.sigmoid(jnp.einsum("btgi,gij->btgj", xblk, w_a).reshape(b, s, LRU_WIDTH).astype(F32) + b_a.astype(F32))
    i = jax.nn.sigmoid(jnp.einsum("btgi,gij->btgj", xblk, w_x).reshape(b, s, LRU_WIDTH).astype(F32) + b_x.astype(F32))
    log_a = -LRU_C * r * jax.nn.softplus(-lam.astype(F32))
    mult = jnp.sqrt(-jnp.expm1(2.0 * log_a))
    h = linear_recurrence_scan(jnp.exp(log_a), mult * i * xb.astype(F32))
    return (h * jax.nn.gelu(gate.astype(F32))).astype(gate.dtype)


def gla_group(q, k, v, g, lowrank, w_gate, b_gate, norm_w):
    log_alpha = jax.nn.log_sigmoid((lowrank @ w_gate).astype(F32) + b_gate.astype(F32)) / GLA_GATE_TAU
    o = chunk_gated_linear_attention(to_heads(q.astype(F32), GLA_HEADS), to_heads(k.astype(F32), GLA_HEADS),
                                     to_heads(v.astype(F32), GLA_HEADS), to_heads(log_alpha, GLA_HEADS), GLA_DK ** -0.5)
    return gated_head_rmsnorm(o, g, norm_w)


def hybrid_mixer(h, w_in, w_out, gdn_conv_w, gdn_a_log, gdn_dt_bias, gdn_norm, hgrn_lb, hgrn_norm,
                 lru_conv_w, lru_conv_b, lru_w_a, lru_b_a, lru_w_x, lru_b_x, lru_lambda,
                 gla_w_gate, gla_b_gate, gla_norm):
    proj = h @ w_in
    splits = [int(c) for c in np.cumsum(IN_SIZES)[:-1]]
    (aq, ak, av, az, aa, ab, bq, bf, bi, bg, cx, cg, dq, dk, dv, dg, dlr) = jnp.split(proj, splits, axis=-1)
    y_a = gated_deltanet_group(aq, ak, av, az, aa, ab, gdn_conv_w, gdn_a_log, gdn_dt_bias, gdn_norm)
    y_b = hgrn2_group(bq, bf, bi, bg, hgrn_lb, hgrn_norm)
    y_c = rglru_group(cx, cg, lru_conv_w, lru_conv_b, lru_w_a, lru_b_a, lru_w_x, lru_b_x, lru_lambda)
    y_d = gla_group(dq, dk, dv, dg, dlr, gla_w_gate, gla_b_gate, gla_norm)
    y = jnp.concatenate([y_a, y_b, y_c, y_d], axis=-1)
    return y @ w_out


def peer_ffn(h, w_q, sub_keys, u, v):
    b, s, d = h.shape
    tokens = h.reshape(-1, PEER_TOKEN_BLOCK, d)

    def block(xb):
        n = xb.shape[0]
        q = (xb @ w_q).astype(F32).reshape(n, PEER_HEADS, 2, PEER_QDIM // 2)
        scores = jnp.einsum("nhpd,hpkd->nhpk", q, sub_keys.astype(F32))
        top_s, top_i = lax.top_k(scores, PEER_TOPK)
        cand_s = (top_s[:, :, 0, :, None] + top_s[:, :, 1, None, :]).reshape(n, PEER_HEADS, -1)
        cand_i = (top_i[:, :, 0, :, None] * PEER_NKEYS + top_i[:, :, 1, None, :]).reshape(n, PEER_HEADS, -1)
        best_s, best_pos = lax.top_k(cand_s, PEER_TOPK)
        experts = jnp.take_along_axis(cand_i, best_pos, axis=-1)
        gates = jax.nn.softmax(best_s, axis=-1)
        u_sel = u[experts]
        v_sel = v[experts]
        act = jax.nn.gelu(jnp.einsum("nd,nhkd->nhk", xb, u_sel).astype(F32))
        coeff = (gates * act).astype(xb.dtype)
        return jnp.einsum("nhk,nhkd->nd", coeff, v_sel)

    return lax.map(block, tokens).reshape(b, s, d)


def setup_inputs(seed: int = 0) -> dict:
    key = jax.random.key(seed)
    ks = jax.random.split(key, 26)
    L, D = DEPTH, D_MODEL

    def nrm(k, shape, scale):
        return scale * jax.random.normal(k, shape, F32)

    def gain(k, shape):
        return 1.0 + 0.02 * jax.random.normal(k, shape, F32)

    dt = jnp.exp(jax.random.uniform(ks[7], (L, GDN_HEADS), F32, math.log(1e-3), math.log(1e-1)))
    a0 = jax.random.uniform(ks[18], (L, LRU_WIDTH), F32, 0.9, 0.999)
    s_lam = a0 ** (1.0 / LRU_C)
    return {
        "x": jax.random.normal(ks[0], (BATCH, SEQ, D), F32),
        "norm_mix": gain(ks[1], (L, D)),
        "norm_ffn": gain(ks[2], (L, D)),
        "norm_final": gain(ks[3], (D,)),
        "w_in": nrm(ks[4], (L, D, D_IN), D ** -0.5),
        "w_out": nrm(ks[5], (L, D_MIX, D), D_MIX ** -0.5),
        "gdn_conv_w": nrm(ks[6], (L, CONV_WIDTH, GDN_HEADS * (2 * GDN_DK + GDN_DV)), CONV_WIDTH ** -0.5),
        "gdn_a_log": jnp.log(jax.random.uniform(ks[8], (L, GDN_HEADS), F32, 1.0, 16.0)),
        "gdn_dt_bias": dt + jnp.log(-jnp.expm1(-dt)),
        "gdn_norm": gain(ks[9], (L, GDN_DV)),
        "hgrn_lb_logits": nrm(ks[10], (L, HGRN_HEADS * HGRN_DK), 0.1),
        "hgrn_norm": gain(ks[11], (L, HGRN_DV)),
        "lru_conv_w": nrm(ks[12], (L, CONV_WIDTH, LRU_WIDTH), CONV_WIDTH ** -0.5),
        "lru_conv_b": nrm(ks[13], (L, LRU_WIDTH), 0.01),
        "lru_w_a": nrm(ks[14], (L, LRU_BLOCKS, LRU_BLOCK_W, LRU_BLOCK_W), LRU_BLOCK_W ** -0.5),
        "lru_b_a": nrm(ks[15], (L, LRU_WIDTH), 0.01),
        "lru_w_x": nrm(ks[16], (L, LRU_BLOCKS, LRU_BLOCK_W, LRU_BLOCK_W), LRU_BLOCK_W ** -0.5),
        "lru_b_x": nrm(ks[17], (L, LRU_WIDTH), 0.01),
        "lru_lambda": jnp.log(s_lam) - jnp.log1p(-s_lam),
        "gla_w_gate": nrm(ks[19], (L, GLA_GATE_RANK, GLA_HEADS * GLA_DK), GLA_GATE_RANK ** -0.5),
        "gla_b_gate": nrm(ks[20], (L, GLA_HEADS * GLA_DK), 0.01),
        "gla_norm": gain(ks[21], (L, GLA_DV)),
        "peer_w_q": nrm(ks[22], (L, D, PEER_HEADS * PEER_QDIM), D ** -0.5),
        "peer_sub_keys": nrm(ks[23], (L, PEER_HEADS, 2, PEER_NKEYS, PEER_QDIM // 2), (PEER_QDIM // 2) ** -0.5),
        "peer_u": nrm(ks[24], (L, PEER_EXPERTS, D), D ** -0.5),
        "peer_v": nrm(ks[25], (L, PEER_EXPERTS, D), PEER_HEADS ** -0.5),
    }


def reference(x, norm_mix, norm_ffn, norm_final, w_in, w_out, gdn_conv_w, gdn_a_log, gdn_dt_bias, gdn_norm,
              hgrn_lb_logits, hgrn_norm, lru_conv_w, lru_conv_b, lru_w_a, lru_b_a, lru_w_x, lru_b_x, lru_lambda,
              gla_w_gate, gla_b_gate, gla_norm, peer_w_q, peer_sub_keys, peer_u, peer_v):
    lb_all = jnp.cumsum(jax.nn.softmax(hgrn_lb_logits.astype(F32), axis=0), axis=0)
    lb_all = lb_all - lb_all[0]
    for l in range(DEPTH):
        h = rmsnorm(x, norm_mix[l])
        x = x + hybrid_mixer(h, w_in[l], w_out[l], gdn_conv_w[l], gdn_a_log[l], gdn_dt_bias[l], gdn_norm[l],
                             lb_all[l], hgrn_norm[l], lru_conv_w[l], lru_conv_b[l], lru_w_a[l], lru_b_a[l],
                             lru_w_x[l], lru_b_x[l], lru_lambda[l], gla_w_gate[l], gla_b_gate[l], gla_norm[l]).astype(x.dtype)
        h = rmsnorm(x, norm_ffn[l])
        x = x + peer_ffn(h, peer_w_q[l], peer_sub_keys[l], peer_u[l], peer_v[l]).astype(x.dtype)
    return rmsnorm(x, norm_final)
```

```cpp
#include <hip/hip_runtime.h>
#include <stdint.h>
#include <cstdio>

#ifndef MK_N_LAUNCHES
#define MK_N_LAUNCHES 1
#endif

#define LAS __attribute__((address_space(3)))
typedef unsigned short bf16_t;
typedef short bf16x8 __attribute__((ext_vector_type(8)));
typedef float f32x4 __attribute__((ext_vector_type(4)));
typedef unsigned u32x4 __attribute__((ext_vector_type(4)));
typedef unsigned u32x2 __attribute__((ext_vector_type(2)));
typedef __bf16 bf16v2 __attribute__((ext_vector_type(2)));

constexpr int DM = 1024, SEQ = 4096, NBATCH = 8, MTOK = NBATCH * SEQ, HM = MTOK / 2, NLAYER = 2;
constexpr int NPROJ = 6680, NPROJP = 6912, AUXW = 2832;
constexpr float EPS = 1e-6f;
constexpr int C_AQ = 0, C_AK = 512, C_AV = 1024, C_BQ = 1536, C_BF = 2048, C_BI = 2560, C_CX = 3072, C_DQ = 3584, C_DK = 3840, C_DV = 4096,
              C_AZ = 4608, C_BG = 5120, C_CG = 5632, C_DG = 6144, C_AA = 6656, C_AB = 6660, C_DLR = 6664, C_Y = 4608;
constexpr int X_Q = 0, X_K = 512, X_V = 1024, X_GOM = 1536, X_LOM = 1792, X_LB = 2304, X_F32 = 2816;
constexpr size_t WS_BAR = 0, WS_RSTD1 = 16384, WS_WIN = WS_RSTD1 + (size_t)MTOK * 4, WS_WOUT = WS_WIN + (size_t)NLAYER * NPROJP * DM * 2,
                 WS_WEFF = WS_WOUT + (size_t)NLAYER * DM * 2048 * 2, WS_LRUW = WS_WEFF + (size_t)NLAYER * 2048 * DM * 2,
                 WS_UBF = WS_LRUW + (size_t)NLAYER * 2 * 4 * 128 * 128 * 2, WS_VBF = WS_UBF + (size_t)16384 * DM * 2, WS_XB = WS_VBF + (size_t)16384 * DM * 2,
                 WS_PROJ = WS_XB + (size_t)MTOK * DM * 2, WS_AUX = WS_PROJ + (size_t)HM * NPROJ * 2, WS_END = WS_AUX + (size_t)HM * AUXW * 2,
                 WS_SCORES = WS_PROJ;
static_assert(WS_END - WS_PROJ >= (size_t)MTOK * 2048 * 4, "scores alias");
static_assert(WS_PROJ % 256 == 0 && WS_AUX % 16 == 0 && WS_WIN % 256 == 0, "alignment");

#define XB_TMO      128
#define XB_XCNT(j)  (256  + 64 * (j))
#define XB_XSUB(j)  (1280 + 64 * (j))
#define XB_XGEN(j)  (2304 + 64 * (j))
#define XB_TOP      3328
#define XB_TOPGEN   3392
#define XCD_BAR_WORDS 3456
#define XB_SPIN_CAP (1u << 24)
__device__ __forceinline__ unsigned xb_ld(unsigned* p)              { return __hip_atomic_load(p, __ATOMIC_RELAXED, __HIP_MEMORY_SCOPE_AGENT); }
__device__ __forceinline__ unsigned xb_add(unsigned* p, unsigned v) { return __hip_atomic_fetch_add(p, v, __ATOMIC_RELAXED, __HIP_MEMORY_SCOPE_AGENT); }
__device__ __forceinline__ unsigned xb_xcc_id() { return (unsigned)__builtin_amdgcn_s_getreg((3 << 11) | 20) & 0xFu; }
#define XB_SPIN(cond, bar) do { unsigned _sp = 0; while (cond) { __builtin_amdgcn_s_sleep(1); \
    if ((++_sp & 255u) == 0u) { if (xb_ld(&(bar)[XB_TMO])) break; if (_sp > XB_SPIN_CAP) { atomicAdd(&(bar)[XB_TMO], 1u); break; } } } } while (0)
struct XcdBarrier { unsigned* bar; unsigned x; volatile LAS unsigned* st; };
__device__ __forceinline__ XcdBarrier xcd_barrier_post(unsigned* bar, volatile LAS unsigned* st) {
    XcdBarrier b; b.bar = bar; b.x = xb_xcc_id(); b.st = st;
    if (threadIdx.x == 0) (void)xb_add(&bar[XB_XCNT(b.x)], 1u);
    return b;
}
__device__ __forceinline__ void xcd_barrier_complete(unsigned* bar, unsigned x, unsigned& nloc, unsigned& nx) {
    const unsigned G = gridDim.x * gridDim.y * gridDim.z;
    unsigned sum, cnt, mine, sp = 0u;
    for (;;) {
        sum = 0u; cnt = 0u; mine = 0u;
#pragma unroll
        for (unsigned j = 0; j < 16; ++j) { const unsigned c = xb_ld(&bar[XB_XCNT(j)]); sum += c; cnt += (c > 0u) ? 1u : 0u; mine = (j == x) ? c : mine; }
        if (sum == G) break;
        __builtin_amdgcn_s_sleep(1);
        if ((++sp & 255u) == 0u) { if (xb_ld(&bar[XB_TMO])) break; if (sp > XB_SPIN_CAP) { atomicAdd(&bar[XB_TMO], 1u); break; } }
    }
    nloc = mine > 0u ? mine : 1u; nx = cnt > 0u ? cnt : 1u;
}
__device__ __forceinline__ void xcd_barrier(const XcdBarrier& b) {
    asm volatile("s_waitcnt vmcnt(0)" ::: "memory");
    __syncthreads();
    if (threadIdx.x == 0) {
        unsigned* bar = b.bar;
        __builtin_amdgcn_s_waitcnt(0);
        unsigned nloc = b.st[0], nx = b.st[1];
        if (nloc == 0u) { xcd_barrier_complete(bar, b.x, nloc, nx); b.st[0] = nloc; b.st[1] = nx; }
        const unsigned old = xb_add(&bar[XB_XSUB(b.x)], 1u);
        const unsigned gen = old / nloc;
        if (old + 1u == (gen + 1u) * nloc) {
            __builtin_amdgcn_fence(__ATOMIC_RELEASE, "agent");
            asm volatile("s_waitcnt vmcnt(0)" ::: "memory");
            const unsigned og = xb_add(&bar[XB_TOP], 1u);
            const unsigned tg = og / nx;
            if (og + 1u == (tg + 1u) * nx) xb_add(&bar[XB_TOPGEN], 1u);
            else XB_SPIN(xb_ld(&bar[XB_TOPGEN]) == tg, bar);
            __builtin_amdgcn_fence(__ATOMIC_ACQUIRE, "agent");
            xb_add(&bar[XB_XGEN(b.x)], 1u);
            asm volatile("s_waitcnt vmcnt(0)" ::: "memory");
        } else {
            XB_SPIN(xb_ld(&bar[XB_XGEN(b.x)]) == gen, bar);
            __builtin_amdgcn_fence(__ATOMIC_ACQUIRE, "agent");
            asm volatile("s_waitcnt vmcnt(0)" ::: "memory");
        }
    }
    __syncthreads();
}

__device__ __forceinline__ float bf_lo(unsigned u) { return __uint_as_float(u << 16); }
__device__ __forceinline__ float bf_hi(unsigned u) { return __uint_as_float(u & 0xffff0000u); }
__device__ __forceinline__ float bf1(bf16_t h) { return __uint_as_float(((unsigned)h) << 16); }
__device__ __forceinline__ unsigned pk_bf16(float lo, float hi) { unsigned r; asm("v_cvt_pk_bf16_f32 %0, %1, %2" : "=v"(r) : "v"(lo), "v"(hi)); return r; }
__device__ __forceinline__ bf16_t to_bf1(float f) { return (bf16_t)(pk_bf16(f, 0.f) & 0xffffu); }
__device__ __forceinline__ void unpack8(const u32x4 v, float (&f)[8]) {
    f[0] = bf_lo(v.x); f[1] = bf_hi(v.x); f[2] = bf_lo(v.y); f[3] = bf_hi(v.y); f[4] = bf_lo(v.z); f[5] = bf_hi(v.z); f[6] = bf_lo(v.w); f[7] = bf_hi(v.w);
}
__device__ __forceinline__ u32x4 pack8(const float (&f)[8]) { u32x4 o; o.x = pk_bf16(f[0], f[1]); o.y = pk_bf16(f[2], f[3]); o.z = pk_bf16(f[4], f[5]); o.w = pk_bf16(f[6], f[7]); return o; }
__device__ __forceinline__ float fast_rcp(float x) { return __builtin_amdgcn_rcpf(x); }
__device__ __forceinline__ float sigmoidf_(float x) { return fast_rcp(1.f + __expf(-x)); }
__device__ __forceinline__ float siluf_(float x) { return x * sigmoidf_(x); }
__device__ __forceinline__ float softplusf_(float x) { return fmaxf(x, 0.f) + log1pf(__expf(-fabsf(x))); }
__device__ __forceinline__ float gelu_tanh(float x) {
    const float u = 0.7978845608028654f * (x + 0.044715f * x * x * x);
    const float t = 1.f - 2.f * fast_rcp(__expf(2.f * u) + 1.f);
    return 0.5f * x * (1.f + t);
}
template <int CTRL> __device__ __forceinline__ float dpp_f(float v) { return __int_as_float(__builtin_amdgcn_update_dpp(0, __float_as_int(v), CTRL, 0xf, 0xf, true)); }
__device__ __forceinline__ float row_sum16(float v) { v += dpp_f<0x128>(v); v += dpp_f<0x124>(v); v += dpp_f<0x122>(v); v += dpp_f<0x121>(v); return v; }
__device__ __forceinline__ float rdlane(float v, int l) { return __int_as_float(__builtin_amdgcn_readlane(__float_as_int(v), l)); }
__device__ __forceinline__ float wave_sum64(float v) { v = row_sum16(v); return (rdlane(v, 0) + rdlane(v, 16)) + (rdlane(v, 32) + rdlane(v, 48)); }

namespace pg8 {
constexpr int BM = 256, BK = 64, HALF = 128, HTB = HALF * BK * 2, STAGE_BYTES = 8 * HTB, NXCD = 8, WGM = 8;
__host__ __device__ __forceinline__ int lds_byte(int r, int c) { const int st = (r >> 4) * 2 + (c >> 5), rr = r & 15, cc = c & 31, ob = rr * 64 + cc * 2; return st * 1024 + (ob ^ (((ob >> 9) & 1) << 5)); }
__host__ __device__ __forceinline__ void stage_rc(int b, int& R, int& C) { const int st = b / 1024, sb = b % 1024, swz = sb ^ (((sb >> 9) & 1) << 5); R = (st >> 1) * 16 + swz / 64; C = (st & 1) * 32 + (swz % 64) / 2; }
__host__ __device__ __forceinline__ int perm32(int rho) { const int n = rho >> 4, i = rho & 15; return 8 * (i >> 2) + 4 * n + (i & 3); }
struct Unit { int pm, pn; };
struct Gemm { const bf16_t* A; const bf16_t* Bt; int M, N, K, lda; };
struct StaticOrder {
    int nM, nN, nwg, G, c;
    __device__ void init(int M, int N, int G_, int c_) { nM = M / BM; nN = N / BM; nwg = nM * nN; G = G_; c = c_; }
    __device__ bool next(int i, Unit& u) const {
        const long L = (long)i * G + c; if (L >= nwg) return false;
        int wgid = (int)L; { const int q = nwg / NXCD, r = nwg % NXCD, xcd = wgid % NXCD, off = wgid / NXCD; wgid = (xcd < r ? xcd * (q + 1) : r * (q + 1) + (xcd - r) * q) + off; }
        const int nig = WGM * nN, gid = wgid / nig, fm = gid * WGM, gsz = (nM - fm) < WGM ? (nM - fm) : WGM;
        u.pm = fm + ((wgid % nig) % gsz); u.pn = (wgid % nig) / gsz; return true;
    }
};
template <class Epi>
__device__ __forceinline__ void gemm_phase(LAS unsigned char* lds, const Gemm g, const StaticOrder& S, const Epi& E) {
    const int tid = threadIdx.x, wid = __builtin_amdgcn_readfirstlane(tid >> 6), lane = tid & 63, wr = wid >> 2, wc = wid & 3, fr = lane & 15, fq = lane >> 4;
    const int K = g.K, nt = K / BK;
    unsigned voffA[2], voffB[2];
#pragma unroll
    for (int i = 0; i < 2; ++i) { int R, C; stage_rc(tid * 16 + i * 8192, R, C); const int Rb = (R & ~31) + perm32(R & 31);
        voffA[i] = (unsigned)(R * g.lda + C) * 2u; voffB[i] = (unsigned)(Rb * K + C) * 2u; }
    const size_t kstep = (size_t)(BK * 2);
    const size_t hsA = (size_t)HALF * g.lda * 2, hsB = (size_t)HALF * K * 2;
    const size_t tsA = 2 * hsA, tsB = 2 * hsB;
    const unsigned ldsw = (unsigned)wid * 1024u;
    const int aoff = lds_byte(wr * 64 + fr, fq * 8), boff = lds_byte(wc * 32 + fr, fq * 8);
#define PG8_SA(b, h) (((b) * 2 + (h)) * HTB)
#define PG8_SB(b, h) ((4 + (b) * 2 + (h)) * HTB)
#define PG8_STAGE(bufoff, gbase, voff) do { _Pragma("unroll") for (int _i = 0; _i < 2; ++_i) \
        __builtin_amdgcn_global_load_lds((const unsigned*)((const char*)(gbase) + (voff)[_i]), (LAS unsigned*)(lds + (bufoff) + ldsw + _i * 8192), 16, 0, 0); } while (0)
#define PG8_LDA(dst, b, h) do { _Pragma("unroll") for (int m = 0; m < 4; ++m) _Pragma("unroll") for (int k = 0; k < 2; ++k) dst[m][k] = *(const LAS bf16x8*)(lds + PG8_SA(b, h) + aoff + m * 2048 + k * 1024); } while (0)
#define PG8_LDB(dst, b, h) do { _Pragma("unroll") for (int n = 0; n < 2; ++n) _Pragma("unroll") for (int k = 0; k < 2; ++k) dst[n][k] = *(const LAS bf16x8*)(lds + PG8_SB(b, h) + boff + n * 2048 + k * 1024); } while (0)
#define PG8_MMA(ai, bj, At, Bt) do { __builtin_amdgcn_s_setprio(1); _Pragma("unroll") for (int m = 0; m < 4; ++m) _Pragma("unroll") for (int n = 0; n < 2; ++n) _Pragma("unroll") for (int k = 0; k < 2; ++k) \
        acc[ai][bj][m][n] = __builtin_amdgcn_mfma_f32_16x16x32_bf16(Bt[n][k], At[m][k], acc[ai][bj][m][n], 0, 0, 0); __builtin_amdgcn_s_setprio(0); } while (0)
#define PG8_WAIT_V(n) asm volatile("s_waitcnt vmcnt(" #n ")" ::: "memory")
#define PG8_WAIT_L(n) asm volatile("s_waitcnt lgkmcnt(" #n ")" ::: "memory")
#define PG8_BAR __builtin_amdgcn_s_barrier()
#define PG8_SCHED __builtin_amdgcn_sched_barrier(0)
    Unit cur, nxt; int ui = 0;
    if (!S.next(0, cur)) return;
    f32x4 acc[2][2][4][2];
#pragma unroll
    for (int a = 0; a < 2; ++a)
#pragma unroll
        for (int b = 0; b < 2; ++b)
#pragma unroll
            for (int m = 0; m < 4; ++m)
#pragma unroll
                for (int n = 0; n < 2; ++n) acc[a][b][m][n] = (f32x4){0.f, 0.f, 0.f, 0.f};
    bf16x8 At[4][2], B0[2][2], B1[2][2];
    const char* cA = (const char*)g.A + (size_t)cur.pm * tsA; const char* cB = (const char*)g.Bt + (size_t)cur.pn * tsB;
    PG8_STAGE(PG8_SB(0, 0), cB, voffB); PG8_STAGE(PG8_SA(0, 0), cA, voffA); PG8_STAGE(PG8_SB(0, 1), cB + hsB, voffB); PG8_STAGE(PG8_SA(0, 1), cA + hsA, voffA);
    if (wr == 1) PG8_BAR;
    PG8_WAIT_V(4); PG8_BAR;
    PG8_STAGE(PG8_SB(1, 0), cB + kstep, voffB); PG8_STAGE(PG8_SA(1, 0), cA + kstep, voffA); PG8_STAGE(PG8_SB(1, 1), cB + hsB + kstep, voffB);
    PG8_WAIT_V(6); PG8_BAR;
    for (;;) {
        const bool has_next = S.next(ui + 1, nxt);
        const char* nA = has_next ? (const char*)g.A + (size_t)nxt.pm * tsA : cA; const char* nB = has_next ? (const char*)g.Bt + (size_t)nxt.pn * tsB : cB;
        for (int t = 0; t < nt; t += 2) {
            const bool last = (t == nt - 2);
            const char* a1 = cA + (size_t)(t + 1) * kstep;
            const char* a2 = last ? nA : cA + (size_t)(t + 2) * kstep; const char* b2 = last ? nB : cB + (size_t)(t + 2) * kstep;
            const char* a3 = a2 + kstep; const char* b3 = b2 + kstep;
            PG8_LDB(B0, 0, 0); PG8_SCHED; PG8_LDA(At, 0, 0); PG8_STAGE(PG8_SA(1, 1), a1 + hsA, voffA);
            PG8_WAIT_L(8); PG8_BAR; PG8_WAIT_L(0); PG8_MMA(0, 0, At, B0); PG8_BAR; PG8_SCHED;
            PG8_LDB(B1, 0, 1); PG8_STAGE(PG8_SB(0, 0), b2, voffB);
            PG8_BAR; PG8_WAIT_L(0); PG8_MMA(0, 1, At, B1); PG8_BAR;
            PG8_LDA(At, 0, 1); PG8_STAGE(PG8_SA(0, 0), a2, voffA);
            PG8_BAR; PG8_WAIT_L(0); PG8_MMA(1, 0, At, B0); PG8_BAR; PG8_SCHED;
            PG8_STAGE(PG8_SB(0, 1), b2 + hsB, voffB);
            PG8_WAIT_V(6); PG8_BAR; PG8_MMA(1, 1, At, B1); PG8_BAR;
            PG8_LDB(B0, 1, 0); PG8_SCHED; PG8_LDA(At, 1, 0); PG8_STAGE(PG8_SA(0, 1), a2 + hsA, voffA);
            PG8_WAIT_L(8); PG8_BAR; PG8_WAIT_L(0); PG8_MMA(0, 0, At, B0); PG8_BAR; PG8_SCHED;
            PG8_LDB(B1, 1, 1); PG8_STAGE(PG8_SB(1, 0), b3, voffB);
            PG8_BAR; PG8_WAIT_L(0); PG8_MMA(0, 1, At, B1); PG8_BAR;
            PG8_LDA(At, 1, 1); PG8_STAGE(PG8_SA(1, 0), a3, voffA);
            PG8_BAR; PG8_WAIT_L(0); PG8_MMA(1, 0, At, B0); PG8_BAR; PG8_SCHED;
            PG8_STAGE(PG8_SB(1, 1), b3 + hsB, voffB);
            PG8_WAIT_V(6); PG8_BAR; PG8_MMA(1, 1, At, B1); PG8_BAR;
        }
        E(acc, cur, wr, wc, fr, fq);
        if (!has_next) break;
#pragma unroll
        for (int a = 0; a < 2; ++a)
#pragma unroll
            for (int b = 0; b < 2; ++b)
#pragma unroll
                for (int m = 0; m < 4; ++m)
#pragma unroll
                    for (int n = 0; n < 2; ++n) acc[a][b][m][n] = (f32x4){0.f, 0.f, 0.f, 0.f};
        cur = nxt; cA = nA; cB = nB; ++ui;
    }
    PG8_WAIT_V(0);
    if (wr == 0) PG8_BAR;
    PG8_BAR;
#undef PG8_SA
#undef PG8_SB
#undef PG8_STAGE
#undef PG8_LDA
#undef PG8_LDB
#undef PG8_MMA
#undef PG8_WAIT_V
#undef PG8_WAIT_L
#undef PG8_BAR
#undef PG8_SCHED
}
struct EpiProj {
    bf16_t* P; const float* rstd;
    __device__ __forceinline__ void operator()(const f32x4 (&acc)[2][2][4][2], const Unit& u, int wr, int wc, int fr, int fq) const {
        const int row0 = u.pm * BM + wr * 64 + fr, col0 = u.pn * BM + wc * 32 + 8 * fq;
#pragma unroll
        for (int ai = 0; ai < 2; ++ai)
#pragma unroll
            for (int m = 0; m < 4; ++m) { const int r = row0 + ai * HALF + m * 16; const float rs = rstd[r]; bf16_t* rowp = P + (size_t)r * NPROJ + col0;
#pragma unroll
                for (int bj = 0; bj < 2; ++bj) { if (col0 + bj * HALF < NPROJ) { const f32x4 v0 = acc[ai][bj][m][0] * rs, v1 = acc[ai][bj][m][1] * rs;
                    u32x4 o; o.x = pk_bf16(v0[0], v0[1]); o.y = pk_bf16(v0[2], v0[3]); o.z = pk_bf16(v1[0], v1[1]); o.w = pk_bf16(v1[2], v1[3]);
                    *(u32x4*)(rowp + bj * HALF) = o; } } }
    }
};
struct EpiResid {
    float* X; bf16_t* XB;
    __device__ __forceinline__ void operator()(const f32x4 (&acc)[2][2][4][2], const Unit& u, int wr, int wc, int fr, int fq) const {
        const int row0 = u.pm * BM + wr * 64 + fr, col0 = u.pn * BM + wc * 32 + 8 * fq;
#pragma unroll
        for (int ai = 0; ai < 2; ++ai)
#pragma unroll
            for (int m = 0; m < 4; ++m) { const size_t off = (size_t)(row0 + ai * HALF + m * 16) * DM + col0;
#pragma unroll
                for (int bj = 0; bj < 2; ++bj) { float* xp = X + off + bj * HALF;
                    const f32x4 v0 = *(const f32x4*)xp + acc[ai][bj][m][0], v1 = *(const f32x4*)(xp + 4) + acc[ai][bj][m][1];
                    *(f32x4*)xp = v0; *(f32x4*)(xp + 4) = v1;
                    u32x4 o; o.x = pk_bf16(v0[0], v0[1]); o.y = pk_bf16(v0[2], v0[3]); o.z = pk_bf16(v1[0], v1[1]); o.w = pk_bf16(v1[2], v1[3]);
                    *(u32x4*)(XB + off + bj * HALF) = o; }
                asm volatile("" ::: "memory"); }
    }
};
struct EpiF32 {
    float* C; int ldc;
    __device__ __forceinline__ void operator()(const f32x4 (&acc)[2][2][4][2], const Unit& u, int wr, int wc, int fr, int fq) const {
        const int row0 = u.pm * BM + wr * 64 + fr, col0 = u.pn * BM + wc * 32 + 8 * fq;
#pragma unroll
        for (int ai = 0; ai < 2; ++ai)
#pragma unroll
            for (int m = 0; m < 4; ++m) { float* rowp = C + (size_t)(row0 + ai * HALF + m * 16) * ldc + col0;
#pragma unroll
                for (int bj = 0; bj < 2; ++bj) { *(f32x4*)(rowp + bj * HALF) = acc[ai][bj][m][0]; *(f32x4*)(rowp + bj * HALF + 4) = acc[ai][bj][m][1]; } }
    }
};
}

struct Args { const float* in[26]; float* out; unsigned char* ws; int lo, hi; };
enum { I_X = 0, I_NMIX, I_NFFN, I_NFIN, I_WIN, I_WOUT, I_GCONV, I_GALOG, I_GDT, I_GNORM, I_HLB, I_HNORM, I_LCONVW, I_LCONVB, I_LWA, I_LBA, I_LWX, I_LBX, I_LLAM,
       I_DWG, I_DBG, I_DNORM, I_PWQ, I_PKEYS, I_PU, I_PV };
constexpr int NTHREADS = 512, NWAVES = 8;
constexpr int LDS_MISC = pg8::STAGE_BYTES;
constexpr int LDS_BYTES = pg8::STAGE_BYTES + 64;

__device__ __forceinline__ int win_srccol(int d) {
    if (d < 1536) return d;
    if (d < 3072) return d + 520;
    if (d < 3584) return d + 1032;
    if (d < 4608) return d + 1544;
    if (d < 5120) return d - 3072;
    if (d < 5632) return d - 1528;
    if (d < 6144) return d - 1016;
    if (d < 6656) return d + 8;
    if (d < 6664) return d - 4608;
    if (d < 6680) return d;
    return -1;
}
template <int MAP>
__device__ __forceinline__ void p0_transpose_item(const float* W, int K, int ldw, int nblk, bf16_t* WT, const float* rowscale, LAS float* scr, int item, int lane) {
    const int kb = item / nblk, nb = item % nblk, k0 = 64 * kb, n0 = 32 * nb;
    int sc = n0 + (lane & 31);
    if (MAP == 1) sc = win_srccol(sc);
#pragma unroll 8
    for (int i = 0; i < 32; ++i) { const int kk = 2 * i + (lane >> 5);
        float v = 0.f;
        if (sc >= 0) { v = W[(size_t)(k0 + kk) * ldw + sc]; if (rowscale) v *= rowscale[k0 + kk]; }
        scr[kk * 33 + (lane & 31)] = v; }
    asm volatile("s_waitcnt lgkmcnt(0)" ::: "memory");
    const int c = lane & 7;
#pragma unroll
    for (int j = 0; j < 4; ++j) { const int n = (lane >> 3) + 8 * j; const LAS float* s = scr + (8 * c) * 33 + n;
        u32x4 o; o.x = pk_bf16(s[0 * 33], s[1 * 33]); o.y = pk_bf16(s[2 * 33], s[3 * 33]); o.z = pk_bf16(s[4 * 33], s[5 * 33]); o.w = pk_bf16(s[6 * 33], s[7 * 33]);
        *(u32x4*)(WT + (size_t)(n0 + n) * K + k0 + 8 * c) = o; }
    asm volatile("s_waitcnt lgkmcnt(0)" ::: "memory");
}
__device__ __forceinline__ void convert_table(const float* src, bf16_t* dst, size_t n, int gtid, int gthreads) {
    const size_t n8 = n / 8;
    for (size_t i = gtid; i < n8; i += gthreads) { const f32x4 a = *(const f32x4*)(src + i * 8), b = *(const f32x4*)(src + i * 8 + 4);
        u32x4 o; o.x = pk_bf16(a[0], a[1]); o.y = pk_bf16(a[2], a[3]); o.z = pk_bf16(b[0], b[1]); o.w = pk_bf16(b[2], b[3]);
        *(u32x4*)(dst + i * 8) = o; }
}
__device__ __forceinline__ void p0_prologue(const Args& A, LAS unsigned char* lds) {
    const int tid = threadIdx.x, lane = tid & 63, wave = __builtin_amdgcn_readfirstlane(tid >> 6), G = gridDim.x, bx = blockIdx.x;
    const int gw = bx * NWAVES + wave, NGW = G * NWAVES;
    unsigned char* ws = A.ws;
    {
        float* X = A.out; bf16_t* XB = (bf16_t*)(ws + WS_XB); float* rstd1 = (float*)(ws + WS_RSTD1);
        for (int row = gw; row < MTOK; row += NGW) {
            const f32x4* xr = (const f32x4*)(A.in[I_X] + (size_t)row * DM) + lane; f32x4 v[4]; float s = 0.f;
#pragma unroll
            for (int j = 0; j < 4; ++j) { v[j] = xr[64 * j]; s += (v[j].x * v[j].x + v[j].y * v[j].y) + (v[j].z * v[j].z + v[j].w * v[j].w); }
            s = wave_sum64(s);
            f32x4* xo = (f32x4*)(X + (size_t)row * DM) + lane; u32x2* bo = (u32x2*)(XB + (size_t)row * DM) + lane;
#pragma unroll
            for (int j = 0; j < 4; ++j) { xo[64 * j] = v[j]; u32x2 o; o.x = pk_bf16(v[j].x, v[j].y); o.y = pk_bf16(v[j].z, v[j].w); bo[64 * j] = o; }
            if (lane == 0) rstd1[row] = rsqrtf(s * (1.f / DM) + EPS);
        }
    }
    {
        LAS float* scr = (LAS float*)(lds + wave * 8704);
        constexpr int NB_IN = NPROJP / 32, I_IN = (DM / 64) * NB_IN, NB_OUT = DM / 32, I_OUT = (2048 / 64) * NB_OUT;
        constexpr int NITEMS = NLAYER * (I_IN + I_OUT);
        for (int it = gw; it < NITEMS; it += NGW) {
            int r = it; const int l = r / (I_IN + I_OUT); r -= l * (I_IN + I_OUT);
            if (r < I_IN) p0_transpose_item<1>(A.in[I_WIN] + (size_t)l * DM * NPROJ, DM, NPROJ, NB_IN, (bf16_t*)(ws + WS_WIN) + (size_t)l * NPROJP * DM, A.in[I_NMIX] + l * DM, scr, r, lane);
            else p0_transpose_item<0>(A.in[I_WOUT] + (size_t)l * 2048 * DM, 2048, DM, NB_OUT, (bf16_t*)(ws + WS_WOUT) + (size_t)l * DM * 2048, nullptr, scr, r - I_IN, lane);
        }
    }
    __syncthreads();
    {
        LAS float* key_s = (LAS float*)lds; LAS float* wq_s = key_s + 128 * 129;
        for (int it = bx; it < NLAYER * 16 * 16; it += G) {
            const int l = it >> 8, hp = (it >> 4) & 15, k0 = (it & 15) * 64;
            const float* keys = A.in[I_PKEYS] + ((size_t)l * 16 + hp) * 128 * 128;
            const float* wq = A.in[I_PWQ] + (size_t)l * DM * 2048 + (size_t)k0 * 2048 + hp * 128;
            for (int e = tid; e < 128 * 128; e += NTHREADS) key_s[(e >> 7) * 129 + (e & 127)] = keys[e];
            for (int e = tid; e < 64 * 128; e += NTHREADS) wq_s[(e >> 7) * 129 + (e & 127)] = wq[(size_t)(e >> 7) * 2048 + (e & 127)];
            __syncthreads();
            const int ks = (tid & 15) * 4, ys = (tid >> 4) * 4;
            float acc[4][4];
#pragma unroll
            for (int i = 0; i < 4; ++i)
#pragma unroll
                for (int j = 0; j < 4; ++j) acc[i][j] = 0.f;
            for (int d = 0; d < 128; ++d) { float a[4], b[4];
#pragma unroll
                for (int i = 0; i < 4; ++i) { a[i] = wq_s[(ks + i) * 129 + d]; b[i] = key_s[(ys + i) * 129 + d]; }
#pragma unroll
                for (int i = 0; i < 4; ++i)
#pragma unroll
                    for (int j = 0; j < 4; ++j) acc[i][j] += a[i] * b[j]; }
            const float* nf = A.in[I_NFFN] + l * DM + k0 + ks;
            bf16_t* wt = (bf16_t*)(ws + WS_WEFF) + (size_t)l * 2048 * DM;
#pragma unroll
            for (int j = 0; j < 4; ++j) { u32x2 o; o.x = pk_bf16(acc[0][j] * nf[0], acc[1][j] * nf[1]); o.y = pk_bf16(acc[2][j] * nf[2], acc[3][j] * nf[3]);
                *(u32x2*)(wt + (size_t)(hp * 128 + ys + j) * DM + k0 + ks) = o; }
            __syncthreads();
        }
    }
    {
        bf16_t* wt = (bf16_t*)(ws + WS_LRUW);
        for (int e = bx * NTHREADS + tid; e < NLAYER * 2 * 4 * 128 * 128; e += G * NTHREADS) {
            const int k = e & 127, n = (e >> 7) & 127, g = (e >> 14) & 3, mat = (e >> 16) & 1, l = e >> 17;
            const float* src = A.in[mat ? I_LWX : I_LWA] + (((size_t)l * 4 + g) * 128 + k) * 128 + n;
            wt[e] = to_bf1(*src);
        }
    }
    convert_table(A.in[I_PU], (bf16_t*)(ws + WS_UBF), (size_t)16384 * DM, bx * NTHREADS + tid, G * NTHREADS);
    convert_table(A.in[I_PV], (bf16_t*)(ws + WS_VBF), (size_t)16384 * DM, bx * NTHREADS + tid, G * NTHREADS);
}

struct ConvW { float w[4][8]; };
__device__ __forceinline__ void load8(const bf16_t* p, float (&f)[8]) { unpack8(*(const u32x4*)p, f); }
__device__ __forceinline__ float hgrn_lb(const Args& A, int l, int c) {
    if (l == 0) return 0.f;
    const float* lg = A.in[I_HLB]; return sigmoidf_(lg[512 + c] - lg[c]);
}
constexpr int XCS = 520;
__device__ __forceinline__ void b1_prep(const Args& A, LAS unsigned char* lds, int l, int half) {
    const int tid = threadIdx.x, lane = tid & 63, wave = __builtin_amdgcn_readfirstlane(tid >> 6), G = gridDim.x;
    bf16_t* proj = (bf16_t*)(A.ws + WS_PROJ); bf16_t* aux = (bf16_t*)(A.ws + WS_AUX);
    LAS bf16_t* xc = (LAS bf16_t*)lds;
    for (int tile = blockIdx.x; tile < HM / 64; tile += G) {
        const int r0 = tile * 64, t0 = (tile & 63) * 64;
        for (int u = wave; u < 24; u += NWAVES) {
            const int p = u >> 3, ch = u & 7, c = p * 512 + lane * 8, ts = t0 + ch * 8, rs = r0 + ch * 8;
            const float* cwp = A.in[I_GCONV] + (size_t)l * 4 * 1536 + c;
            float cw[4][8];
#pragma unroll
            for (int w = 0; w < 4; ++w) { const f32x4 a = *(const f32x4*)(cwp + w * 1536), b = *(const f32x4*)(cwp + w * 1536 + 4);
                cw[w][0] = a[0]; cw[w][1] = a[1]; cw[w][2] = a[2]; cw[w][3] = a[3]; cw[w][4] = b[0]; cw[w][5] = b[1]; cw[w][6] = b[2]; cw[w][7] = b[3]; }
            float x3[8], x2[8], x1[8], x0[8];
            if (ts >= 3) { load8(proj + (size_t)(rs - 3) * NPROJ + c, x3); load8(proj + (size_t)(rs - 2) * NPROJ + c, x2); load8(proj + (size_t)(rs - 1) * NPROJ + c, x1); }
            else {
#pragma unroll
                for (int j = 0; j < 8; ++j) { x3[j] = 0.f; x2[j] = 0.f; x1[j] = 0.f; } }
#pragma unroll
            for (int i = 0; i < 8; ++i) {
                load8(proj + (size_t)(rs + i) * NPROJ + c, x0);
                float o[8]; float ss = 0.f;
#pragma unroll
                for (int j = 0; j < 8; ++j) { const float v = cw[0][j] * x3[j] + cw[1][j] * x2[j] + cw[2][j] * x1[j] + cw[3][j] * x0[j]; o[j] = siluf_(v); ss += o[j] * o[j]; }
                if (p < 2) { ss = row_sum16(ss); const float sc = rsqrtf(ss + EPS);
#pragma unroll
                    for (int j = 0; j < 8; ++j) o[j] *= sc; }
                *(u32x4*)(aux + (size_t)(rs + i) * AUXW + c) = pack8(o);
#pragma unroll
                for (int j = 0; j < 8; ++j) { x3[j] = x2[j]; x2[j] = x1[j]; x1[j] = x0[j]; }
            }
        }
        if (tid < 256) { const int tk = tid >> 2, h = tid & 3; const size_t row = (size_t)(r0 + tk);
            const float a = bf1(proj[row * NPROJ + C_AA + h]), b = bf1(proj[row * NPROJ + C_AB + h]);
            const float g = -__expf(A.in[I_GALOG][l * 4 + h]) * softplusf_(a + A.in[I_GDT][l * 4 + h]);
            float* f = (float*)(aux + row * AUXW + X_F32); f[h] = __expf(g); f[4 + h] = sigmoidf_(b); }
        for (int e = tid; e < 64 * 128; e += NTHREADS) { const int tk = e >> 7, cc = (e & 127) * 8; bf16_t* p = proj + (size_t)(r0 + tk) * NPROJ + C_BQ + cc;
            float v[8]; load8(p, v);
            if (cc < 512) {
#pragma unroll
                for (int j = 0; j < 8; ++j) v[j] = siluf_(v[j]); }
            else {
#pragma unroll
                for (int j = 0; j < 8; ++j) v[j] = (1.f - hgrn_lb(A, l, cc - 512 + j)) * sigmoidf_(-v[j]); }
            *(u32x4*)p = pack8(v); }
        { const int tk = tid >> 3, ob = (tid & 7) * 32; const size_t row = (size_t)(r0 + tk);
            float lr[16]; { float t8[8]; load8(proj + row * NPROJ + C_DLR, t8);
#pragma unroll
                for (int j = 0; j < 8; ++j) lr[j] = t8[j];
                load8(proj + row * NPROJ + C_DLR + 8, t8);
#pragma unroll
                for (int j = 0; j < 8; ++j) lr[8 + j] = t8[j]; }
            const float* wg = A.in[I_DWG] + (size_t)l * 16 * 256 + ob; const float* bg = A.in[I_DBG] + l * 256 + ob;
#pragma unroll 1
            for (int q = 0; q < 4; ++q) { float o[8];
#pragma unroll
                for (int j = 0; j < 8; ++j) o[j] = bg[q * 8 + j];
#pragma unroll
                for (int r = 0; r < 16; ++r) { const f32x4 a = *(const f32x4*)(wg + r * 256 + q * 8), b = *(const f32x4*)(wg + r * 256 + q * 8 + 4);
                    o[0] += lr[r] * a[0]; o[1] += lr[r] * a[1]; o[2] += lr[r] * a[2]; o[3] += lr[r] * a[3]; o[4] += lr[r] * b[0]; o[5] += lr[r] * b[1]; o[6] += lr[r] * b[2]; o[7] += lr[r] * b[3]; }
#pragma unroll
                for (int j = 0; j < 8; ++j) o[j] = -expm1f(-softplusf_(-o[j]) * (1.f / 16.f));
                *(u32x4*)(aux + row * AUXW + X_GOM + ob + q * 8) = pack8(o); } }
        { const int ch = wave, c = lane * 8, ts = t0 + ch * 8, rs = r0 + ch * 8;
            const float* cwp = A.in[I_LCONVW] + (size_t)l * 4 * 512 + c; const float* cbp = A.in[I_LCONVB] + l * 512 + c;
            float cw[4][8], cb[8];
#pragma unroll
            for (int w = 0; w < 4; ++w) { const f32x4 a = *(const f32x4*)(cwp + w * 512), b = *(const f32x4*)(cwp + w * 512 + 4);
                cw[w][0] = a[0]; cw[w][1] = a[1]; cw[w][2] = a[2]; cw[w][3] = a[3]; cw[w][4] = b[0]; cw[w][5] = b[1]; cw[w][6] = b[2]; cw[w][7] = b[3]; }
            { const f32x4 a = *(const f32x4*)cbp, b = *(const f32x4*)(cbp + 4); cb[0] = a[0]; cb[1] = a[1]; cb[2] = a[2]; cb[3] = a[3]; cb[4] = b[0]; cb[5] = b[1]; cb[6] = b[2]; cb[7] = b[3]; }
            float x3[8], x2[8], x1[8], x0[8];
            const bf16_t* src = proj + C_CX + c;
            if (ts >= 3) { load8(src + (size_t)(rs - 3) * NPROJ, x3); load8(src + (size_t)(rs - 2) * NPROJ, x2); load8(src + (size_t)(rs - 1) * NPROJ, x1); }
            else {
#pragma unroll
                for (int j = 0; j < 8; ++j) { x3[j] = 0.f; x2[j] = 0.f; x1[j] = 0.f; } }
#pragma unroll
            for (int i = 0; i < 8; ++i) {
                load8(src + (size_t)(rs + i) * NPROJ, x0);
                float o[8];
#pragma unroll
                for (int j = 0; j < 8; ++j) o[j] = cb[j] + cw[0][j] * x3[j] + cw[1][j] * x2[j] + cw[2][j] * x1[j] + cw[3][j] * x0[j];
                *(LAS u32x4*)(xc + (ch * 8 + i) * XCS + c) = pack8(o);
#pragma unroll
                for (int j = 0; j < 8; ++j) { x3[j] = x2[j]; x2[j] = x1[j]; x1[j] = x0[j]; }
            }
        }
        __syncthreads();
        { const int g = wave >> 1, nh = wave & 1, fr = lane & 15, fq = lane >> 4;
            const bf16_t* wa = (const bf16_t*)(A.ws + WS_LRUW) + (((size_t)l * 2 + 0) * 4 + g) * 128 * 128;
            const bf16_t* wx = (const bf16_t*)(A.ws + WS_LRUW) + (((size_t)l * 2 + 1) * 4 + g) * 128 * 128;
#pragma unroll 1
            for (int nt = 0; nt < 4; ++nt) {
                const int n = nh * 64 + nt * 16 + fr, cch = g * 128 + n;
                bf16x8 ba[4], bx[4];
#pragma unroll
                for (int ks = 0; ks < 4; ++ks) { ba[ks] = *(const bf16x8*)(wa + (size_t)n * 128 + ks * 32 + fq * 8); bx[ks] = *(const bf16x8*)(wx + (size_t)n * 128 + ks * 32 + fq * 8); }
                const float b_a = A.in[I_LBA][l * 512 + cch], b_x = A.in[I_LBX][l * 512 + cch], spl = softplusf_(-A.in[I_LLAM][l * 512 + cch]);
#pragma unroll 1
                for (int m = 0; m < 4; ++m) {
                    f32x4 ca = {0.f, 0.f, 0.f, 0.f}, cx = {0.f, 0.f, 0.f, 0.f};
#pragma unroll
                    for (int ks = 0; ks < 4; ++ks) { const bf16x8 af = *(const LAS bf16x8*)(xc + (m * 16 + fr) * XCS + g * 128 + ks * 32 + fq * 8);
                        ca = __builtin_amdgcn_mfma_f32_16x16x32_bf16(af, ba[ks], ca, 0, 0, 0); cx = __builtin_amdgcn_mfma_f32_16x16x32_bf16(af, bx[ks], cx, 0, 0, 0); }
#pragma unroll
                    for (int j = 0; j < 4; ++j) { const int tk = m * 16 + fq * 4 + j;
                        const float r = sigmoidf_(ca[j] + b_a), ig = sigmoidf_(cx[j] + b_x), la = -8.f * r * spl;
                        const float om = -expm1f(la), mult = sqrtf(-expm1f(2.f * la)), xv = bf1(xc[tk * XCS + cch]);
                        bf16_t* ap = aux + (size_t)(r0 + tk) * AUXW; ap[X_LOM + cch] = to_bf1(om); ap[X_LB + cch] = to_bf1(mult * ig * xv); }
                }
            }
        }
        __syncthreads();
    }
}

template <int MODE>
__device__ __forceinline__ void scan_unit(LAS unsigned char* lds, bf16_t* proj, bf16_t* aux, int bb, int h, int dvq) {
    constexpr int KPL = (MODE == 2) ? 4 : 8, DK = KPL * 16, TC = 64;
    const int tid = threadIdx.x, lane = tid & 63, wave = __builtin_amdgcn_readfirstlane(tid >> 6), kg = lane & 15, dvi = lane >> 4;
    LAS bf16_t* qb = (LAS bf16_t*)lds;
    LAS bf16_t* kb = qb + TC * DK;
    LAS bf16_t* mb = kb + TC * DK;
    LAS bf16_t* vb = mb + TC * DK;
    LAS float* db = (LAS float*)(vb + TC * 32);
    LAS bf16_t* ob = (LAS bf16_t*)(db + 2 * TC);
    const size_t rbase = (size_t)bb * SEQ;
    const bf16_t *qsrc, *ksrc, *msrc = nullptr; bf16_t* vsrc; int qld, vld, mld = 0;
    if (MODE == 0) { qsrc = aux + X_Q + h * 128; ksrc = aux + X_K + h * 128; vsrc = aux + X_V + h * 128 + dvq * 32; qld = AUXW; vld = AUXW; }
    else if (MODE == 1) { qsrc = proj + C_BQ + h * 128; ksrc = proj + C_BF + h * 128; vsrc = proj + C_BI + h * 128 + dvq * 32; qld = NPROJ; vld = NPROJ; }
    else { qsrc = proj + C_DQ + h * 64; ksrc = proj + C_DK + h * 64; msrc = aux + X_GOM + h * 64; mld = AUXW; vsrc = proj + C_DV + h * 128 + dvq * 32; qld = NPROJ; vld = NPROJ; }
    constexpr int CPR = DK / 8;
    constexpr int NQ = TC * CPR / NTHREADS;
    u32x4 rq[NQ], rk[NQ], rm[NQ], rv; float rd = 0.f, rb = 0.f;
    rv = (u32x4){0u, 0u, 0u, 0u};
#define SCAN_GLOAD(c_) do { const size_t row0 = rbase + (size_t)(c_) * TC; \
        _Pragma("unroll") for (int i = 0; i < NQ; ++i) { const int e = tid + i * NTHREADS, r = e / CPR, cc = (e % CPR) * 8; \
            rq[i] = *(const u32x4*)(qsrc + (row0 + r) * qld + cc); rk[i] = *(const u32x4*)(ksrc + (row0 + r) * qld + cc); \
            if (MODE == 2) rm[i] = *(const u32x4*)(msrc + (row0 + r) * mld + cc); } \
        if (tid < TC * 4) { const int r = tid >> 2, cc = (tid & 3) * 8; rv = *(const u32x4*)(vsrc + (row0 + r) * vld + cc); } \
        if (MODE == 0 && tid < TC) { const float* f = (const float*)(aux + (row0 + tid) * AUXW + X_F32); rd = f[h]; rb = f[4 + h]; } } while (0)
#define SCAN_LSTORE() do { \
        _Pragma("unroll") for (int i = 0; i < NQ; ++i) { const int e = tid + i * NTHREADS, r = e / CPR, cc = (e % CPR) * 8; \
            *(LAS u32x4*)(qb + r * DK + cc) = rq[i]; *(LAS u32x4*)(kb + r * DK + cc) = rk[i]; \
            if (MODE == 2) *(LAS u32x4*)(mb + r * DK + cc) = rm[i]; } \
        if (tid < TC * 4) { const int r = tid >> 2, cc = (tid & 3) * 8; *(LAS u32x4*)(vb + r * 32 + cc) = rv; } \
        if (MODE == 0 && tid < TC) { db[tid] = rd; db[TC + tid] = rb; } } while (0)
    float S[KPL];
#pragma unroll
    for (int j = 0; j < KPL; ++j) S[j] = 0.f;
    SCAN_GLOAD(0); SCAN_LSTORE();
    __syncthreads();
    for (int c = 0; c < SEQ / TC; ++c) {
        if (c + 1 < SEQ / TC) SCAN_GLOAD(c + 1);
#pragma unroll 4
        for (int t = 0; t < TC; ++t) {
            float qf[KPL], kf[KPL], mf[KPL];
            if (KPL == 8) { float t8[8]; unpack8(*(const LAS u32x4*)(qb + t * DK + kg * 8), t8);
#pragma unroll
                for (int j = 0; j < KPL; ++j) qf[j] = t8[j];
                unpack8(*(const LAS u32x4*)(kb + t * DK + kg * 8), t8);
#pragma unroll
                for (int j = 0; j < KPL; ++j) kf[j] = t8[j]; }
            else { const u32x2 a = *(const LAS u32x2*)(qb + t * DK + kg * 4), b = *(const LAS u32x2*)(kb + t * DK + kg * 4), m = *(const LAS u32x2*)(mb + t * DK + kg * 4);
                qf[0] = bf_lo(a.x); qf[1] = bf_hi(a.x); qf[2] = bf_lo(a.y); qf[3] = bf_hi(a.y);
                kf[0] = bf_lo(b.x); kf[1] = bf_hi(b.x); kf[2] = bf_lo(b.y); kf[3] = bf_hi(b.y);
                mf[0] = bf_lo(m.x); mf[1] = bf_hi(m.x); mf[2] = bf_lo(m.y); mf[3] = bf_hi(m.y); }
            const float v = bf1(vb[t * 32 + wave * 4 + dvi]);
            float o = 0.f;
            if (MODE == 0) {
                const float d = db[t], beta = db[TC + t];
                float ks = 0.f;
#pragma unroll
                for (int j = 0; j < KPL; ++j) ks += kf[j] * S[j];
                ks = row_sum16(ks);
                const float vn = beta * (v - d * ks);
#pragma unroll
                for (int j = 0; j < KPL; ++j) { S[j] = fmaf(kf[j], vn, d * S[j]); o += qf[j] * S[j]; }
            } else if (MODE == 1) {
#pragma unroll
                for (int j = 0; j < KPL; ++j) { S[j] = fmaf(1.f - kf[j], S[j], kf[j] * v); o += qf[j] * S[j]; }
            } else {
#pragma unroll
                for (int j = 0; j < KPL; ++j) { S[j] = fmaf(1.f - mf[j], S[j], kf[j] * v); o += qf[j] * S[j]; }
            }
            o = row_sum16(o);
            if (kg == 0) ob[t * 32 + wave * 4 + dvi] = to_bf1(o);
        }
        __syncthreads();
        if (tid < TC * 4) { const int r = tid >> 2, cc = (tid & 3) * 8; *(u32x4*)(vsrc + (rbase + (size_t)c * TC + r) * vld + cc) = *(const LAS u32x4*)(ob + r * 32 + cc); }
        if (c + 1 < SEQ / TC) SCAN_LSTORE();
        __syncthreads();
    }
}
#undef SCAN_GLOAD
#undef SCAN_LSTORE
__device__ __forceinline__ void lru_unit(LAS unsigned char* lds, bf16_t* aux, int bb, int cg) {
    const int tid = threadIdx.x, ch = tid & 31, seg = tid >> 5;
    LAS float* P = (LAS float*)lds; LAS float* Hs = P + 512;
    bf16_t* base = aux + ((size_t)bb * SEQ + (size_t)seg * 256) * AUXW + cg * 32 + ch;
    float p = 1.f, hv = 0.f;
#pragma unroll 8
    for (int t = 0; t < 256; ++t) { const float a = 1.f - bf1(base[(size_t)t * AUXW + X_LOM]), b = bf1(base[(size_t)t * AUXW + X_LB]); hv = fmaf(a, hv, b); p *= a; }
    P[tid] = p; Hs[tid] = hv;
    __syncthreads();
    float carry = 0.f;
    for (int s = 0; s < seg; ++s) carry = fmaf(P[s * 32 + ch], carry, Hs[s * 32 + ch]);
    hv = carry;
#pragma unroll 8
    for (int t = 0; t < 256; ++t) { const float a = 1.f - bf1(base[(size_t)t * AUXW + X_LOM]), b = bf1(base[(size_t)t * AUXW + X_LB]); hv = fmaf(a, hv, b); base[(size_t)t * AUXW + X_LB] = to_bf1(hv); }
    __syncthreads();
}
__device__ __forceinline__ void b2_scan(const Args& A, LAS unsigned char* lds) {
    bf16_t* proj = (bf16_t*)(A.ws + WS_PROJ); bf16_t* aux = (bf16_t*)(A.ws + WS_AUX);
    for (int u = blockIdx.x; u < 256; u += gridDim.x) {
        const int kind = u >> 6, r = u & 63;
        if (kind == 0) scan_unit<0>(lds, proj, aux, r >> 4, (r >> 2) & 3, r & 3);
        else if (kind == 1) scan_unit<1>(lds, proj, aux, r >> 4, (r >> 2) & 3, r & 3);
        else if (kind == 2) scan_unit<2>(lds, proj, aux, r >> 4, (r >> 2) & 3, r & 3);
        else lru_unit(lds, aux, r >> 4, r & 15);
    }
}

__device__ __forceinline__ void b3_post(const Args& A, int l) {
    const int tid = threadIdx.x, lane = tid & 63, wave = __builtin_amdgcn_readfirstlane(tid >> 6), G = gridDim.x;
    bf16_t* proj = (bf16_t*)(A.ws + WS_PROJ); bf16_t* aux = (bf16_t*)(A.ws + WS_AUX);
    const int cin = (lane & 15) * 8;
    float wn[3][8];
    { const float* p0 = A.in[I_GNORM] + l * 128 + cin; const float* p1 = A.in[I_HNORM] + l * 128 + cin; const float* p2 = A.in[I_DNORM] + l * 128 + cin;
#pragma unroll
        for (int j = 0; j < 8; ++j) { wn[0][j] = p0[j]; wn[1][j] = p1[j]; wn[2][j] = p2[j]; } }
    for (int row = blockIdx.x * NWAVES + wave; row < HM; row += G * NWAVES) {
        bf16_t* pr = proj + (size_t)row * NPROJ; const bf16_t* ar = aux + (size_t)row * AUXW;
        float o[8], g[8], y[8];
        load8(ar + X_V + lane * 8, o); load8(pr + C_AZ + lane * 8, g);
        { float ss = 0.f;
#pragma unroll
            for (int j = 0; j < 8; ++j) { o[j] *= 0.08838834764831845f; ss += o[j] * o[j]; }
            ss = row_sum16(ss); const float r = rsqrtf(ss * (1.f / 128.f) + EPS);
#pragma unroll
            for (int j = 0; j < 8; ++j) y[j] = o[j] * r * wn[0][j] * siluf_(g[j]);
            *(u32x4*)(pr + C_AZ + lane * 8) = pack8(y); }
        load8(pr + C_BI + lane * 8, o); load8(pr + C_BG + lane * 8, g);
        { float ss = 0.f;
#pragma unroll
            for (int j = 0; j < 8; ++j) { o[j] *= 0.08838834764831845f; ss += o[j] * o[j]; }
            ss = row_sum16(ss); const float r = rsqrtf(ss * (1.f / 128.f) + EPS);
#pragma unroll
            for (int j = 0; j < 8; ++j) y[j] = o[j] * r * wn[1][j] * siluf_(g[j]);
            *(u32x4*)(pr + C_BG + lane * 8) = pack8(y); }
        load8(ar + X_LB + lane * 8, o); load8(pr + C_CG + lane * 8, g);
#pragma unroll
        for (int j = 0; j < 8; ++j) y[j] = o[j] * gelu_tanh(g[j]);
        *(u32x4*)(pr + C_CG + lane * 8) = pack8(y);
        load8(pr + C_DV + lane * 8, o); load8(pr + C_DG + lane * 8, g);
        { float ss = 0.f;
#pragma unroll
            for (int j = 0; j < 8; ++j) { o[j] *= 0.125f; ss += o[j] * o[j]; }
            ss = row_sum16(ss); const float r = rsqrtf(ss * (1.f / 128.f) + EPS);
#pragma unroll
            for (int j = 0; j < 8; ++j) y[j] = o[j] * r * wn[2][j] * siluf_(g[j]);
            *(u32x4*)(pr + C_DG + lane * 8) = pack8(y); }
    }
}

__device__ const unsigned char PAIR_IJ[56] = {
    0x00, 0x01, 0x02, 0x03, 0x04, 0x05, 0x06, 0x07, 0x08, 0x09, 0x0A, 0x0B, 0x0C, 0x0D, 0x0E, 0x0F,
    0x10, 0x11, 0x12, 0x13, 0x14, 0x15, 0x16, 0x17, 0x20, 0x21, 0x22, 0x23, 0x24, 0x30, 0x31, 0x32, 0x33,
    0x40, 0x41, 0x42, 0x50, 0x51, 0x60, 0x61, 0x70, 0x71, 0x80, 0x90, 0xA0, 0xB0, 0xC0, 0xD0, 0xE0, 0xF0,
    0xFF, 0xFF, 0xFF, 0xFF, 0xFF, 0xFF };
__device__ __forceinline__ float fmax_dpp_quad(float m) { m = fmaxf(m, dpp_f<0xB1>(m)); m = fmaxf(m, dpp_f<0x4E>(m)); return m; }
__device__ __forceinline__ float dot2bf(unsigned a, unsigned b, float acc) {
    return __builtin_amdgcn_fdot2_f32_bf16(__builtin_bit_cast(bf16v2, a), __builtin_bit_cast(bf16v2, b), acc, false);
}
__device__ __forceinline__ float dot8(const u32x4 a, const unsigned* hb, float acc) {
    const unsigned a0 = a.x, a1 = a.y, a2 = a.z, a3 = a.w;
    acc = dot2bf(a0, hb[0], acc); acc = dot2bf(a1, hb[1], acc); acc = dot2bf(a2, hb[2], acc); acc = dot2bf(a3, hb[3], acc);
    return acc;
}
__device__ __forceinline__ void axpy8(const u32x4 v, float c, float* acc) {
    acc[0] = fmaf(c, bf_lo(v.x), acc[0]); acc[1] = fmaf(c, bf_hi(v.x), acc[1]); acc[2] = fmaf(c, bf_lo(v.y), acc[2]); acc[3] = fmaf(c, bf_hi(v.y), acc[3]);
    acc[4] = fmaf(c, bf_lo(v.z), acc[4]); acc[5] = fmaf(c, bf_hi(v.z), acc[5]); acc[6] = fmaf(c, bf_lo(v.w), acc[6]); acc[7] = fmaf(c, bf_hi(v.w), acc[7]);
}
__device__ __forceinline__ void pe_peer(const Args& A, LAS unsigned char* lds, int l, bool last) {
    const int tid = threadIdx.x, lane = tid & 63, wave = __builtin_amdgcn_readfirstlane(tid >> 6), G = gridDim.x;
    const float NEG_INF = __uint_as_float(0xFF800000u);
    LAS unsigned* tl = (LAS unsigned*)(lds + wave * 2048);
    LAS unsigned* el = tl + 256;
    LAS float* gl = (LAS float*)(el + 128);
    float* X = A.out; bf16_t* XB = (bf16_t*)(A.ws + WS_XB); float* rstd1 = (float*)(A.ws + WS_RSTD1);
    const float* SC = (const float*)(A.ws + WS_SCORES);
    const bf16_t* U = (const bf16_t*)(A.ws + WS_UBF); const bf16_t* V = (const bf16_t*)(A.ws + WS_VBF);
    const float* nf = A.in[I_NFFN] + l * DM; const float* nfin = A.in[I_NFIN];
    for (int n = blockIdx.x * NWAVES + wave; n < MTOK; n += G * NWAVES) {
        unsigned hb[8]; float rstd2;
        { const float* xr = X + (size_t)n * DM + 8 * lane;
            const f32x4 a0 = *(const f32x4*)xr, a1 = *(const f32x4*)(xr + 4), b0 = *(const f32x4*)(xr + 512), b1 = *(const f32x4*)(xr + 516);
            float ss = (a0[0] * a0[0] + a0[1] * a0[1]) + (a0[2] * a0[2] + a0[3] * a0[3]) + (a1[0] * a1[0] + a1[1] * a1[1]) + (a1[2] * a1[2] + a1[3] * a1[3])
                     + (b0[0] * b0[0] + b0[1] * b0[1]) + (b0[2] * b0[2] + b0[3] * b0[3]) + (b1[0] * b1[0] + b1[1] * b1[1]) + (b1[2] * b1[2] + b1[3] * b1[3]);
            ss = wave_sum64(ss); rstd2 = rsqrtf(ss * (1.f / DM) + EPS);
            const f32x4 w0 = *(const f32x4*)(nf + 8 * lane), w1 = *(const f32x4*)(nf + 8 * lane + 4), w2 = *(const f32x4*)(nf + 512 + 8 * lane), w3 = *(const f32x4*)(nf + 516 + 8 * lane);
            hb[0] = pk_bf16(a0[0] * rstd2 * w0[0], a0[1] * rstd2 * w0[1]); hb[1] = pk_bf16(a0[2] * rstd2 * w0[2], a0[3] * rstd2 * w0[3]);
            hb[2] = pk_bf16(a1[0] * rstd2 * w1[0], a1[1] * rstd2 * w1[1]); hb[3] = pk_bf16(a1[2] * rstd2 * w1[2], a1[3] * rstd2 * w1[3]);
            hb[4] = pk_bf16(b0[0] * rstd2 * w2[0], b0[1] * rstd2 * w2[1]); hb[5] = pk_bf16(b0[2] * rstd2 * w2[2], b0[3] * rstd2 * w2[3]);
            hb[6] = pk_bf16(b1[0] * rstd2 * w3[0], b1[1] * rstd2 * w3[1]); hb[7] = pk_bf16(b1[2] * rstd2 * w3[2], b1[3] * rstd2 * w3[3]); }
        {
            const int sub = lane & 3, gidx = lane >> 2;
            const float* sp = SC + (size_t)n * 2048 + gidx * 128 + sub * 32;
            float val[32];
#pragma unroll
            for (int q = 0; q < 8; ++q) { const f32x4 s = *(const f32x4*)(sp + q * 4);
#pragma unroll
                for (int j = 0; j < 4; ++j) val[q * 4 + j] = __uint_as_float((__float_as_uint(s[j]) & ~0x7Fu) | (unsigned)(sub * 32 + q * 4 + j)); }
            float top[16];
#pragma unroll
            for (int it = 0; it < 16; ++it) {
                float m = val[0];
#pragma unroll
                for (int i = 1; i < 32; ++i) m = fmaxf(m, val[i]);
                m = fmax_dpp_quad(m);
                top[it] = m;
#pragma unroll
                for (int i = 0; i < 32; ++i) val[i] = (__float_as_uint(val[i]) == __float_as_uint(m)) ? NEG_INF : val[i];
            }
            if (sub == 0) {
#pragma unroll
                for (int it = 0; it < 16; ++it) tl[gidx * 16 + it] = __float_as_uint(top[it]); }
        }
        __builtin_amdgcn_wave_barrier(); asm volatile("s_waitcnt lgkmcnt(0)" ::: "memory");
        {
            const int hh = lane >> 3, slot = lane & 7;
            float cand[7];
#pragma unroll
            for (int q = 0; q < 7; ++q) { const unsigned code = PAIR_IJ[slot + 8 * q];
                if (code != 0xFFu) { const float a = __uint_as_float(tl[(2 * hh) * 16 + (code >> 4)] & ~0x7Fu), b = __uint_as_float(tl[(2 * hh + 1) * 16 + (code & 15u)] & ~0x7Fu);
                    cand[q] = __uint_as_float((__float_as_uint(a + b) & ~0xFFu) | code); }
                else cand[q] = NEG_INF; }
            float best[16];
#pragma unroll
            for (int it = 0; it < 16; ++it) {
                float m = cand[0];
#pragma unroll
                for (int q = 1; q < 7; ++q) m = fmaxf(m, cand[q]);
                m = fmax_dpp_quad(m); m = fmaxf(m, dpp_f<0x141>(m));
                best[it] = m;
#pragma unroll
                for (int q = 0; q < 7; ++q) cand[q] = (__float_as_uint(cand[q]) == __float_as_uint(m)) ? NEG_INF : cand[q];
            }
            const float b0 = __uint_as_float(__float_as_uint(best[0]) & ~0xFFu);
            float e[16], es = 0.f;
#pragma unroll
            for (int k = 0; k < 16; ++k) { e[k] = __expf((__uint_as_float(__float_as_uint(best[k]) & ~0xFFu) - b0) * rstd2); es += e[k]; }
            const float inv = 1.f / es;
#pragma unroll
            for (int k = 0; k < 16; ++k) if ((k & 7) == slot) { const unsigned code = __float_as_uint(best[k]) & 0xFFu;
                const unsigned i0 = tl[(2 * hh) * 16 + (code >> 4)] & 0x7Fu, i1 = tl[(2 * hh + 1) * 16 + (code & 15u)] & 0x7Fu;
                el[hh * 16 + k] = i0 * 128u + i1; gl[hh * 16 + k] = e[k] * inv; }
        }
        __builtin_amdgcn_wave_barrier(); asm volatile("s_waitcnt lgkmcnt(0)" ::: "memory");
        float acc[16];
#pragma unroll
        for (int i = 0; i < 16; ++i) acc[i] = 0.f;
#pragma unroll 1
        for (int b = 0; b < 32; ++b) {
            u32x4 ua[4], ub[4], va[4], vb[4];
#pragma unroll
            for (int r = 0; r < 4; ++r) { const unsigned e = (unsigned)__builtin_amdgcn_readfirstlane((int)el[b * 4 + r]);
                const bf16_t* up = U + (size_t)e * DM + 8 * lane; const bf16_t* vp = V + (size_t)e * DM + 8 * lane;
                ua[r] = *(const u32x4*)up; ub[r] = *(const u32x4*)(up + 512); va[r] = *(const u32x4*)vp; vb[r] = *(const u32x4*)(vp + 512); }
#pragma unroll
            for (int r = 0; r < 4; ++r) {
                float p = dot8(ua[r], hb, 0.f); p = dot8(ub[r], hb + 4, p);
                p = wave_sum64(p);
                const float c = gl[b * 4 + r] * gelu_tanh(p);
                axpy8(va[r], c, acc); axpy8(vb[r], c, acc + 8);
            }
        }
        { float* xr = X + (size_t)n * DM + 8 * lane;
            f32x4 a0 = *(const f32x4*)xr, a1 = *(const f32x4*)(xr + 4), b0 = *(const f32x4*)(xr + 512), b1 = *(const f32x4*)(xr + 516);
#pragma unroll
            for (int j = 0; j < 4; ++j) { a0[j] += acc[j]; a1[j] += acc[4 + j]; b0[j] += acc[8 + j]; b1[j] += acc[12 + j]; }
            float ss = (a0[0] * a0[0] + a0[1] * a0[1]) + (a0[2] * a0[2] + a0[3] * a0[3]) + (a1[0] * a1[0] + a1[1] * a1[1]) + (a1[2] * a1[2] + a1[3] * a1[3])
                     + (b0[0] * b0[0] + b0[1] * b0[1]) + (b0[2] * b0[2] + b0[3] * b0[3]) + (b1[0] * b1[0] + b1[1] * b1[1]) + (b1[2] * b1[2] + b1[3] * b1[3]);
            ss = wave_sum64(ss); const float rs = rsqrtf(ss * (1.f / DM) + EPS);
            if (!last) {
                *(f32x4*)xr = a0; *(f32x4*)(xr + 4) = a1; *(f32x4*)(xr + 512) = b0; *(f32x4*)(xr + 516) = b1;
                bf16_t* bp = XB + (size_t)n * DM + 8 * lane;
                u32x4 o; o.x = pk_bf16(a0[0], a0[1]); o.y = pk_bf16(a0[2], a0[3]); o.z = pk_bf16(a1[0], a1[1]); o.w = pk_bf16(a1[2], a1[3]); *(u32x4*)bp = o;
                o.x = pk_bf16(b0[0], b0[1]); o.y = pk_bf16(b0[2], b0[3]); o.z = pk_bf16(b1[0], b1[1]); o.w = pk_bf16(b1[2], b1[3]); *(u32x4*)(bp + 512) = o;
                if (lane == 0) rstd1[n] = rs;
            } else {
                const f32x4 w0 = *(const f32x4*)(nfin + 8 * lane), w1 = *(const f32x4*)(nfin + 8 * lane + 4), w2 = *(const f32x4*)(nfin + 512 + 8 * lane), w3 = *(const f32x4*)(nfin + 516 + 8 * lane);
                *(f32x4*)xr = a0 * rs * w0; *(f32x4*)(xr + 4) = a1 * rs * w1; *(f32x4*)(xr + 512) = b0 * rs * w2; *(f32x4*)(xr + 516) = b1 * rs * w3;
            }
        }
        __builtin_amdgcn_wave_barrier(); asm volatile("s_waitcnt lgkmcnt(0)" ::: "memory");
    }
}

__global__ void __launch_bounds__(NTHREADS, 2) fwd_kernel(Args A) {
    extern __shared__ __attribute__((aligned(16))) unsigned char smem[];
    LAS unsigned char* lds = (LAS unsigned char*)smem;
    const int tid = threadIdx.x, G = gridDim.x;
    const int lo = A.lo, hi = A.hi;
#define IN(k) (lo <= (k) && (k) < hi)
#define BOTH(k) (IN(k) && IN((k) + 1))
    volatile LAS unsigned* misc = (volatile LAS unsigned*)(lds + LDS_MISC);
    if (tid < 16) misc[tid] = 0u;
    __syncthreads();
    XcdBarrier bar; bar.bar = (unsigned*)(A.ws + WS_BAR); bar.x = 0; bar.st = misc;
    if (hi - lo > 1) bar = xcd_barrier_post((unsigned*)(A.ws + WS_BAR), misc);
#define SEAM(k) do { if (BOTH(k)) xcd_barrier(bar); } while (0)

#ifndef PHM
#define PHM 0xFF
#endif
    if (IN(0)) { if (PHM & 1) p0_prologue(A, lds); SEAM(0); }
#define RUN_HALF(l, half) do { \
        const int ph = 1 + (l) * 12 + (half) * 5; \
        if (IN(ph + 0)) { \
            if ((l) > 0 && (half) == 0) { \
                convert_table(A.in[I_PU] + (size_t)(l) * 16384 * DM, (bf16_t*)(A.ws + WS_UBF), (size_t)16384 * DM, blockIdx.x * NTHREADS + tid, G * NTHREADS); \
                convert_table(A.in[I_PV] + (size_t)(l) * 16384 * DM, (bf16_t*)(A.ws + WS_VBF), (size_t)16384 * DM, blockIdx.x * NTHREADS + tid, G * NTHREADS); \
            } \
            pg8::Gemm g{(const bf16_t*)(A.ws + WS_XB) + (size_t)(half) * HM * DM, (const bf16_t*)(A.ws + WS_WIN) + (size_t)(l) * NPROJP * DM, HM, NPROJP, DM, DM}; \
            pg8::StaticOrder S; S.init(HM, NPROJP, G, (int)blockIdx.x); \
            pg8::EpiProj E{(bf16_t*)(A.ws + WS_PROJ), (const float*)(A.ws + WS_RSTD1) + (half) * HM}; \
            if (PHM & 2) pg8::gemm_phase<pg8::EpiProj>(lds, g, S, E); \
            SEAM(ph + 0); \
        } \
        if (IN(ph + 1)) { if (PHM & 4) b1_prep(A, lds, (l), (half)); SEAM(ph + 1); } \
        if (IN(ph + 2)) { if (PHM & 8) b2_scan(A, lds); SEAM(ph + 2); } \
        if (IN(ph + 3)) { if (PHM & 16) b3_post(A, (l)); SEAM(ph + 3); } \
        if (IN(ph + 4)) { \
            pg8::Gemm g{(const bf16_t*)(A.ws + WS_PROJ) + C_Y, (const bf16_t*)(A.ws + WS_WOUT) + (size_t)(l) * DM * 2048, HM, DM, 2048, NPROJ}; \
            pg8::StaticOrder S; S.init(HM, DM, G, (int)blockIdx.x); \
            pg8::EpiResid E{A.out + (size_t)(half) * HM * DM, (bf16_t*)(A.ws + WS_XB) + (size_t)(half) * HM * DM}; \
            if (PHM & 32) pg8::gemm_phase<pg8::EpiResid>(lds, g, S, E); \
            SEAM(ph + 4); \
        } } while (0)
#define RUN_TAIL(l) do { \
        const int pb = 1 + (l) * 12; \
        if (IN(pb + 10)) { \
            pg8::Gemm g{(const bf16_t*)(A.ws + WS_XB), (const bf16_t*)(A.ws + WS_WEFF) + (size_t)(l) * 2048 * DM, MTOK, 2048, DM, DM}; \
            pg8::StaticOrder S; S.init(MTOK, 2048, G, (int)blockIdx.x); \
            pg8::EpiF32 E{(float*)(A.ws + WS_SCORES), 2048}; \
            if (PHM & 64) pg8::gemm_phase<pg8::EpiF32>(lds, g, S, E); \
            SEAM(pb + 10); \
        } \
        if (IN(pb + 11)) { if (PHM & 128) pe_peer(A, lds, (l), (l) == NLAYER - 1); SEAM(pb + 11); } } while (0)
    RUN_HALF(0, 0); RUN_HALF(0, 1); RUN_TAIL(0);
    RUN_HALF(1, 0); RUN_HALF(1, 1); RUN_TAIL(1);
#undef RUN_HALF
#undef RUN_TAIL
#undef IN
#undef BOTH
#undef SEAM
}
constexpr int NPHASES = 1 + NLAYER * 12;

extern "C" void kernel_launch(void* const* d_in, const int* in_sizes, int n_in, void* d_out, int out_size, void* d_ws, size_t ws_size, hipStream_t stream) {
    static int grid = 0;
    if (grid == 0) {
        if (n_in != 26 || out_size != MTOK * DM || ws_size < WS_END) { fprintf(stderr, "kernel_launch: unexpected shapes (n_in %d out %d ws %zu need %zu)\n", n_in, out_size, ws_size, (size_t)WS_END); grid = -1; return; }
        int dev = 0, cus = 0;
        if (hipGetDevice(&dev) != hipSuccess || hipDeviceGetAttribute(&cus, hipDeviceAttributeMultiprocessorCount, dev) != hipSuccess) { grid = -1; return; }
        if (hipFuncSetAttribute((const void*)fwd_kernel, hipFuncAttributeMaxDynamicSharedMemorySize, LDS_BYTES) != hipSuccess) { fprintf(stderr, "kernel_launch: hipFuncSetAttribute failed\n"); grid = -1; return; }
        int per_cu = 0;
        if (hipOccupancyMaxActiveBlocksPerMultiprocessor(&per_cu, (const void*)fwd_kernel, NTHREADS, LDS_BYTES) != hipSuccess || per_cu < 1) { fprintf(stderr, "kernel_launch: occupancy query says %d\n", per_cu); (void)hipGetLastError(); }
        grid = cus;
    }
    if (grid < 0) return;
    (void)hipMemsetAsync((char*)d_ws + WS_BAR, 0, 16384, stream);
    Args a{};
    for (int i = 0; i < 26; ++i) a.in[i] = (const float*)d_in[i];
    a.out = (float*)d_out; a.ws = (unsigned char*)d_ws;
#if MK_N_LAUNCHES == 1
    a.lo = 0; a.hi = NPHASES;
    hipLaunchKernelGGL(fwd_kernel, dim3(grid), dim3(NTHREADS), LDS_BYTES, stream, a);
#else
    for (int p = 0; p < NPHASES; ++p) { a.lo = p; a.hi = p + 1; hipLaunchKernelGGL(fwd_kernel, dim3(grid), dim3(NTHREADS), LDS_BYTES, stream, a); }
#endif
}
```

```cpp
#include <hip/hip_runtime.h>
#include <stdint.h>
#include <cstdio>

#ifndef MK_N_LAUNCHES
#define MK_N_LAUNCHES 1
#endif

#define LAS __attribute__((address_space(3)))
typedef unsigned short bf16_t;
typedef short bf16x8 __attribute__((ext_vector_type(8)));
typedef float f32x4 __attribute__((ext_vector_type(4)));
typedef unsigned u32x4 __attribute__((ext_vector_type(4)));
typedef unsigned u32x2 __attribute__((ext_vector_type(2)));
typedef __bf16 bf16v2 __attribute__((ext_vector_type(2)));

constexpr int DM = 1024, SEQ = 4096, NBATCH = 8, MTOK = NBATCH * SEQ, HM = MTOK / 2, NLAYER = 2;
constexpr int NPROJ = 6680, NPROJP = 6912;
constexpr float EPS = 1e-6f;
constexpr int C_AQ = 0, C_AK = 512, C_AV = 1024, C_BQ = 1536, C_BF = 2048, C_BI = 2560, C_CX = 3072, C_DQ = 3584, C_DK = 3840, C_DV = 4096,
              C_AZ = 4608, C_BG = 5120, C_CG = 5632, C_DG = 6144, C_AA = 6656, C_AB = 6660, C_DLR = 6664, C_Y = 4608;
constexpr int NCI = 1024;
constexpr size_t AX_GW = 0,
                 AX_GQ = AX_GW + (size_t)NCI * 64 * 128 * 2,
                 AX_GUT = AX_GQ + (size_t)NCI * 64 * 128 * 2,
                 AX_GKT = AX_GUT + (size_t)NCI * 64 * 128 * 2,
                 AX_GO = AX_GKT + (size_t)NCI * 64 * 128 * 2,
                 AX_GQK = AX_GO + (size_t)NCI * 64 * 128 * 2,
                 AX_GGL = AX_GQK + (size_t)NCI * 64 * 64 * 2,
                 AX_HATT = AX_GGL + (size_t)NCI * 4,
                 AX_HKT = AX_HATT + (size_t)NCI * 64 * 64 * 2,
                 AX_HGD = AX_HKT + (size_t)NCI * 128 * 64 * 2,
                 AX_DATT = AX_HGD + (size_t)NCI * 128 * 4,
                 AX_DKT = AX_DATT + (size_t)NCI * 64 * 64 * 2,
                 AX_DGD = AX_DKT + (size_t)NCI * 64 * 64 * 2,
                 AX_LOM = AX_DGD + (size_t)NCI * 64 * 4,
                 AX_LB = AX_LOM + (size_t)HM * 512 * 2,
                 AX_END = AX_LB + (size_t)HM * 512 * 2;
constexpr size_t WS_BAR = 0, WS_RSTD1 = 16384, WS_WIN = WS_RSTD1 + (size_t)MTOK * 4, WS_WOUT = WS_WIN + (size_t)NLAYER * NPROJP * DM * 2,
                 WS_WEFF = WS_WOUT + (size_t)NLAYER * DM * 2048 * 2, WS_LRUW = WS_WEFF + (size_t)NLAYER * 2048 * DM * 2,
                 WS_SU = WS_LRUW + (size_t)NLAYER * 2 * 4 * 128 * 128 * 2, WS_SV = WS_SU + (size_t)16384 * 4, WS_XB = WS_SV + (size_t)16384 * 4,
                 WS_PROJ = WS_XB + (size_t)MTOK * DM * 2, WS_AUX = WS_PROJ + (size_t)HM * NPROJ * 2, WS_END = WS_AUX + AX_END,
                 WS_SCORES = WS_PROJ,
                 WS_U8 = WS_SCORES + (size_t)MTOK * 2048 * 4,
                 WS_V8 = WS_U8 + (size_t)16384 * DM;
static_assert(WS_V8 + (size_t)16384 * DM <= WS_END, "scores + expert tables alias");
static_assert(WS_PROJ % 256 == 0 && WS_AUX % 16 == 0 && WS_WIN % 256 == 0 && AX_GGL % 16 == 0 && AX_HATT % 16 == 0 && AX_LOM % 16 == 0, "alignment");

#define XB_TMO      128
#define XB_XCNT(j)  (256  + 64 * (j))
#define XB_XSUB(j)  (1280 + 64 * (j))
#define XB_XGEN(j)  (2304 + 64 * (j))
#define XB_TOP      3328
#define XB_TOPGEN   3392
#define XCD_BAR_WORDS 3456
#define XB_SPIN_CAP (1u << 24)
__device__ __forceinline__ unsigned xb_ld(unsigned* p)              { return __hip_atomic_load(p, __ATOMIC_RELAXED, __HIP_MEMORY_SCOPE_AGENT); }
__device__ __forceinline__ unsigned xb_add(unsigned* p, unsigned v) { return __hip_atomic_fetch_add(p, v, __ATOMIC_RELAXED, __HIP_MEMORY_SCOPE_AGENT); }
__device__ __forceinline__ unsigned xb_xcc_id() { return (unsigned)__builtin_amdgcn_s_getreg((3 << 11) | 20) & 0xFu; }
#define XB_SPIN(cond, bar) do { unsigned _sp = 0; while (cond) { __builtin_amdgcn_s_sleep(1); \
    if ((++_sp & 255u) == 0u) { if (xb_ld(&(bar)[XB_TMO])) break; if (_sp > XB_SPIN_CAP) { atomicAdd(&(bar)[XB_TMO], 1u); break; } } } } while (0)
struct XcdBarrier { unsigned* bar; unsigned x; volatile LAS unsigned* st; };
__device__ __forceinline__ XcdBarrier xcd_barrier_post(unsigned* bar, volatile LAS unsigned* st) {
    XcdBarrier b; b.bar = bar; b.x = xb_xcc_id(); b.st = st;
    if (threadIdx.x == 0) (void)xb_add(&bar[XB_XCNT(b.x)], 1u);
    return b;
}
__device__ __forceinline__ void xcd_barrier_complete(unsigned* bar, unsigned x, unsigned& nloc, unsigned& nx) {
    const unsigned G = gridDim.x * gridDim.y * gridDim.z;
    unsigned sum, cnt, mine, sp = 0u;
    for (;;) {
        sum = 0u; cnt = 0u; mine = 0u;
#pragma unroll
        for (unsigned j = 0; j < 16; ++j) { const unsigned c = xb_ld(&bar[XB_XCNT(j)]); sum += c; cnt += (c > 0u) ? 1u : 0u; mine = (j == x) ? c : mine; }
        if (sum == G) break;
        __builtin_amdgcn_s_sleep(1);
        if ((++sp & 255u) == 0u) { if (xb_ld(&bar[XB_TMO])) break; if (sp > XB_SPIN_CAP) { atomicAdd(&bar[XB_TMO], 1u); break; } }
    }
    nloc = mine > 0u ? mine : 1u; nx = cnt > 0u ? cnt : 1u;
}
__device__ __forceinline__ void xcd_barrier(const XcdBarrier& b) {
    asm volatile("s_waitcnt vmcnt(0)" ::: "memory");
    __syncthreads();
    if (threadIdx.x == 0) {
        unsigned* bar = b.bar;
        __builtin_amdgcn_s_waitcnt(0);
        unsigned nloc = b.st[0], nx = b.st[1];
        if (nloc == 0u) { xcd_barrier_complete(bar, b.x, nloc, nx); b.st[0] = nloc; b.st[1] = nx; }
        const unsigned old = xb_add(&bar[XB_XSUB(b.x)], 1u);
        const unsigned gen = old / nloc;
        if (old + 1u == (gen + 1u) * nloc) {
            __builtin_amdgcn_fence(__ATOMIC_RELEASE, "agent");
            asm volatile("s_waitcnt vmcnt(0)" ::: "memory");
            const unsigned og = xb_add(&bar[XB_TOP], 1u);
            const unsigned tg = og / nx;
            if (og + 1u == (tg + 1u) * nx) xb_add(&bar[XB_TOPGEN], 1u);
            else XB_SPIN(xb_ld(&bar[XB_TOPGEN]) == tg, bar);
            __builtin_amdgcn_fence(__ATOMIC_ACQUIRE, "agent");
            xb_add(&bar[XB_XGEN(b.x)], 1u);
            asm volatile("s_waitcnt vmcnt(0)" ::: "memory");
        } else {
            XB_SPIN(xb_ld(&bar[XB_XGEN(b.x)]) == gen, bar);
            __builtin_amdgcn_fence(__ATOMIC_ACQUIRE, "agent");
            asm volatile("s_waitcnt vmcnt(0)" ::: "memory");
        }
    }
    __syncthreads();
}

__device__ __forceinline__ float bf_lo(unsigned u) { return __uint_as_float(u << 16); }
__device__ __forceinline__ float bf_hi(unsigned u) { return __uint_as_float(u & 0xffff0000u); }
__device__ __forceinline__ float bf1(bf16_t h) { return __uint_as_float(((unsigned)h) << 16); }
__device__ __forceinline__ unsigned pk_bf16(float lo, float hi) { bf16v2 v; v.x = (__bf16)lo; v.y = (__bf16)hi; return __builtin_bit_cast(unsigned, v); }
__device__ __forceinline__ bf16_t to_bf1(float f) { return (bf16_t)(pk_bf16(f, 0.f) & 0xffffu); }
__device__ __forceinline__ void unpack8(const u32x4 v, float (&f)[8]) {
    f[0] = bf_lo(v.x); f[1] = bf_hi(v.x); f[2] = bf_lo(v.y); f[3] = bf_hi(v.y); f[4] = bf_lo(v.z); f[5] = bf_hi(v.z); f[6] = bf_lo(v.w); f[7] = bf_hi(v.w);
}
__device__ __forceinline__ u32x4 pack8(const float (&f)[8]) { u32x4 o; o.x = pk_bf16(f[0], f[1]); o.y = pk_bf16(f[2], f[3]); o.z = pk_bf16(f[4], f[5]); o.w = pk_bf16(f[6], f[7]); return o; }
__device__ __forceinline__ float fast_rcp(float x) { return __builtin_amdgcn_rcpf(x); }
__device__ __forceinline__ float sigmoidf_(float x) { return fast_rcp(1.f + __expf(-x)); }
__device__ __forceinline__ float siluf_(float x) { return x * sigmoidf_(x); }
__device__ __forceinline__ float softplusf_(float x) { return fmaxf(x, 0.f) + log1pf(__expf(-fabsf(x))); }
__device__ __forceinline__ float gelu_tanh(float x) {
    const float u = 0.7978845608028654f * (x + 0.044715f * x * x * x);
    const float t = 1.f - 2.f * fast_rcp(__expf(2.f * u) + 1.f);
    return 0.5f * x * (1.f + t);
}
template <int CTRL> __device__ __forceinline__ float dpp_f(float v) { return __int_as_float(__builtin_amdgcn_update_dpp(0, __float_as_int(v), CTRL, 0xf, 0xf, true)); }
__device__ __forceinline__ float row_sum16(float v) { v += dpp_f<0x128>(v); v += dpp_f<0x124>(v); v += dpp_f<0x122>(v); v += dpp_f<0x121>(v); return v; }
__device__ __forceinline__ float rdlane(float v, int l) { return __int_as_float(__builtin_amdgcn_readlane(__float_as_int(v), l)); }
__device__ __forceinline__ float wave_sum64(float v) { v = row_sum16(v); return (rdlane(v, 0) + rdlane(v, 16)) + (rdlane(v, 32) + rdlane(v, 48)); }

namespace pg8 {
constexpr int BM = 256, BK = 64, HALF = 128, HTB = HALF * BK * 2, STAGE_BYTES = 8 * HTB, NXCD = 8, WGM = 8;
__host__ __device__ __forceinline__ int lds_byte(int r, int c) { const int st = (r >> 4) * 2 + (c >> 5), rr = r & 15, cc = c & 31, ob = rr * 64 + cc * 2; return st * 1024 + (ob ^ (((ob >> 9) & 1) << 5)); }
__host__ __device__ __forceinline__ void stage_rc(int b, int& R, int& C) { const int st = b / 1024, sb = b % 1024, swz = sb ^ (((sb >> 9) & 1) << 5); R = (st >> 1) * 16 + swz / 64; C = (st & 1) * 32 + (swz % 64) / 2; }
__host__ __device__ __forceinline__ int perm32(int rho) { const int n = rho >> 4, i = rho & 15; return 8 * (i >> 2) + 4 * n + (i & 3); }
struct Unit { int pm, pn; };
struct Gemm { const bf16_t* A; const bf16_t* Bt; int M, N, K, lda; };
struct StaticOrder {
    int nM, nN, nwg, G, c;
    __device__ void init(int M, int N, int G_, int c_) { nM = M / BM; nN = N / BM; nwg = nM * nN; G = G_; c = c_; }
    __device__ bool next(int i, Unit& u) const {
        const long L = (long)i * G + c; if (L >= nwg) return false;
        int wgid = (int)L; { const int q = nwg / NXCD, r = nwg % NXCD, xcd = wgid % NXCD, off = wgid / NXCD; wgid = (xcd < r ? xcd * (q + 1) : r * (q + 1) + (xcd - r) * q) + off; }
        const int nig = WGM * nN, gid = wgid / nig, fm = gid * WGM, gsz = (nM - fm) < WGM ? (nM - fm) : WGM;
        u.pm = fm + ((wgid % nig) % gsz); u.pn = (wgid % nig) / gsz; return true;
    }
};
template <class Epi>
__device__ __forceinline__ void gemm_phase(LAS unsigned char* lds, const Gemm g, const StaticOrder& S, const Epi& E) {
    const int tid = threadIdx.x, wid = __builtin_amdgcn_readfirstlane(tid >> 6), lane = tid & 63, wr = wid >> 2, wc = wid & 3, fr = lane & 15, fq = lane >> 4;
    const int K = g.K, nt = K / BK;
    unsigned voffA[2], voffB[2];
#pragma unroll
    for (int i = 0; i < 2; ++i) { int R, C; stage_rc(tid * 16 + i * 8192, R, C); const int Rb = (R & ~31) + perm32(R & 31);
        voffA[i] = (unsigned)(R * g.lda + C) * 2u; voffB[i] = (unsigned)(Rb * K + C) * 2u; }
    const size_t kstep = (size_t)(BK * 2);
    const size_t hsA = (size_t)HALF * g.lda * 2, hsB = (size_t)HALF * K * 2;
    const size_t tsA = 2 * hsA, tsB = 2 * hsB;
    const unsigned ldsw = (unsigned)wid * 1024u;
    const int aoff = lds_byte(wr * 64 + fr, fq * 8), boff = lds_byte(wc * 32 + fr, fq * 8);
#define PG8_SA(b, h) (((b) * 2 + (h)) * HTB)
#define PG8_SB(b, h) ((4 + (b) * 2 + (h)) * HTB)
#define PG8_STAGE(bufoff, gbase, voff) do { _Pragma("unroll") for (int _i = 0; _i < 2; ++_i) \
        __builtin_amdgcn_global_load_lds((const unsigned*)((const char*)(gbase) + (voff)[_i]), (LAS unsigned*)(lds + (bufoff) + ldsw + _i * 8192), 16, 0, 0); } while (0)
#define PG8_LDA(dst, b, h) do { _Pragma("unroll") for (int m = 0; m < 4; ++m) _Pragma("unroll") for (int k = 0; k < 2; ++k) dst[m][k] = *(const LAS bf16x8*)(lds + PG8_SA(b, h) + aoff + m * 2048 + k * 1024); } while (0)
#define PG8_LDB(dst, b, h) do { _Pragma("unroll") for (int n = 0; n < 2; ++n) _Pragma("unroll") for (int k = 0; k < 2; ++k) dst[n][k] = *(const LAS bf16x8*)(lds + PG8_SB(b, h) + boff + n * 2048 + k * 1024); } while (0)
#define PG8_MMA(ai, bj, At, Bt) do { __builtin_amdgcn_s_setprio(1); _Pragma("unroll") for (int m = 0; m < 4; ++m) _Pragma("unroll") for (int n = 0; n < 2; ++n) _Pragma("unroll") for (int k = 0; k < 2; ++k) \
        acc[ai][bj][m][n] = __builtin_amdgcn_mfma_f32_16x16x32_bf16(Bt[n][k], At[m][k], acc[ai][bj][m][n], 0, 0, 0); __builtin_amdgcn_s_setprio(0); } while (0)
#define PG8_WAIT_V(n) asm volatile("s_waitcnt vmcnt(" #n ")" ::: "memory")
#define PG8_WAIT_L(n) asm volatile("s_waitcnt lgkmcnt(" #n ")" ::: "memory")
#define PG8_BAR __builtin_amdgcn_s_barrier()
#define PG8_SCHED __builtin_amdgcn_sched_barrier(0)
    Unit cur, nxt; int ui = 0;
    if (!S.next(0, cur)) return;
    f32x4 acc[2][2][4][2];
#pragma unroll
    for (int a = 0; a < 2; ++a)
#pragma unroll
        for (int b = 0; b < 2; ++b)
#pragma unroll
            for (int m = 0; m < 4; ++m)
#pragma unroll
                for (int n = 0; n < 2; ++n) acc[a][b][m][n] = (f32x4){0.f, 0.f, 0.f, 0.f};
    bf16x8 At[4][2], B0[2][2], B1[2][2];
    const char* cA = (const char*)g.A + (size_t)cur.pm * tsA; const char* cB = (const char*)g.Bt + (size_t)cur.pn * tsB;
    PG8_STAGE(PG8_SB(0, 0), cB, voffB); PG8_STAGE(PG8_SA(0, 0), cA, voffA); PG8_STAGE(PG8_SB(0, 1), cB + hsB, voffB); PG8_STAGE(PG8_SA(0, 1), cA + hsA, voffA);
    if (wr == 1) PG8_BAR;
    PG8_WAIT_V(4); PG8_BAR;
    PG8_STAGE(PG8_SB(1, 0), cB + kstep, voffB); PG8_STAGE(PG8_SA(1, 0), cA + kstep, voffA); PG8_STAGE(PG8_SB(1, 1), cB + hsB + kstep, voffB);
    PG8_WAIT_V(6); PG8_BAR;
    for (;;) {
        const bool has_next = S.next(ui + 1, nxt);
        const char* nA = has_next ? (const char*)g.A + (size_t)nxt.pm * tsA : cA; const char* nB = has_next ? (const char*)g.Bt + (size_t)nxt.pn * tsB : cB;
        for (int t = 0; t < nt; t += 2) {
            const bool last = (t == nt - 2);
            const char* a1 = cA + (size_t)(t + 1) * kstep;
            const char* a2 = last ? nA : cA + (size_t)(t + 2) * kstep; const char* b2 = last ? nB : cB + (size_t)(t + 2) * kstep;
            const char* a3 = a2 + kstep; const char* b3 = b2 + kstep;
            PG8_LDB(B0, 0, 0); PG8_SCHED; PG8_LDA(At, 0, 0); PG8_STAGE(PG8_SA(1, 1), a1 + hsA, voffA);
            PG8_WAIT_L(8); PG8_BAR; PG8_WAIT_L(0); PG8_MMA(0, 0, At, B0); PG8_BAR; PG8_SCHED;
            PG8_LDB(B1, 0, 1); PG8_STAGE(PG8_SB(0, 0), b2, voffB);
            PG8_BAR; PG8_WAIT_L(0); PG8_MMA(0, 1, At, B1); PG8_BAR;
            PG8_LDA(At, 0, 1); PG8_STAGE(PG8_SA(0, 0), a2, voffA);
            PG8_BAR; PG8_WAIT_L(0); PG8_MMA(1, 0, At, B0); PG8_BAR; PG8_SCHED;
            PG8_STAGE(PG8_SB(0, 1), b2 + hsB, voffB);
            PG8_WAIT_V(6); PG8_BAR; PG8_MMA(1, 1, At, B1); PG8_BAR;
            PG8_LDB(B0, 1, 0); PG8_SCHED; PG8_LDA(At, 1, 0); PG8_STAGE(PG8_SA(0, 1), a2 + hsA, voffA);
            PG8_WAIT_L(8); PG8_BAR; PG8_WAIT_L(0); PG8_MMA(0, 0, At, B0); PG8_BAR; PG8_SCHED;
            PG8_LDB(B1, 1, 1); PG8_STAGE(PG8_SB(1, 0), b3, voffB);
            PG8_BAR; PG8_WAIT_L(0); PG8_MMA(0, 1, At, B1); PG8_BAR;
            PG8_LDA(At, 1, 1); PG8_STAGE(PG8_SA(1, 0), a3, voffA);
            PG8_BAR; PG8_WAIT_L(0); PG8_MMA(1, 0, At, B0); PG8_BAR; PG8_SCHED;
            PG8_STAGE(PG8_SB(1, 1), b3 + hsB, voffB);
            PG8_WAIT_V(6); PG8_BAR; PG8_MMA(1, 1, At, B1); PG8_BAR;
        }
        E(acc, cur, wr, wc, fr, fq);
        if (!has_next) break;
#pragma unroll
        for (int a = 0; a < 2; ++a)
#pragma unroll
            for (int b = 0; b < 2; ++b)
#pragma unroll
                for (int m = 0; m < 4; ++m)
#pragma unroll
                    for (int n = 0; n < 2; ++n) acc[a][b][m][n] = (f32x4){0.f, 0.f, 0.f, 0.f};
        cur = nxt; cA = nA; cB = nB; ++ui;
    }
    PG8_WAIT_V(0);
    if (wr == 0) PG8_BAR;
    PG8_BAR;
#undef PG8_SA
#undef PG8_SB
#undef PG8_STAGE
#undef PG8_LDA
#undef PG8_LDB
#undef PG8_MMA
#undef PG8_WAIT_V
#undef PG8_WAIT_L
#undef PG8_BAR
#undef PG8_SCHED
}
struct EpiProj {
    bf16_t* P; const float* rstd;
    __device__ __forceinline__ void operator()(const f32x4 (&acc)[2][2][4][2], const Unit& u, int wr, int wc, int fr, int fq) const {
        const int row0 = u.pm * BM + wr * 64 + fr, col0 = u.pn * BM + wc * 32 + 8 * fq;
#pragma unroll
        for (int ai = 0; ai < 2; ++ai)
#pragma unroll
            for (int m = 0; m < 4; ++m) { const int r = row0 + ai * HALF + m * 16; const float rs = rstd[r]; bf16_t* rowp = P + (size_t)r * NPROJ + col0;
#pragma unroll
                for (int bj = 0; bj < 2; ++bj) { if (col0 + bj * HALF < NPROJ) { const f32x4 v0 = acc[ai][bj][m][0] * rs, v1 = acc[ai][bj][m][1] * rs;
                    u32x4 o; o.x = pk_bf16(v0[0], v0[1]); o.y = pk_bf16(v0[2], v0[3]); o.z = pk_bf16(v1[0], v1[1]); o.w = pk_bf16(v1[2], v1[3]);
                    *(u32x4*)(rowp + bj * HALF) = o; } } }
    }
};
struct EpiResid {
    float* X; bf16_t* XB;
    __device__ __forceinline__ void operator()(const f32x4 (&acc)[2][2][4][2], const Unit& u, int wr, int wc, int fr, int fq) const {
        const int row0 = u.pm * BM + wr * 64 + fr, col0 = u.pn * BM + wc * 32 + 8 * fq;
#pragma unroll
        for (int ai = 0; ai < 2; ++ai)
#pragma unroll
            for (int m = 0; m < 4; ++m) { const size_t off = (size_t)(row0 + ai * HALF + m * 16) * DM + col0;
#pragma unroll
                for (int bj = 0; bj < 2; ++bj) { float* xp = X + off + bj * HALF;
                    const f32x4 v0 = *(const f32x4*)xp + acc[ai][bj][m][0], v1 = *(const f32x4*)(xp + 4) + acc[ai][bj][m][1];
                    *(f32x4*)xp = v0; *(f32x4*)(xp + 4) = v1;
                    u32x4 o; o.x = pk_bf16(v0[0], v0[1]); o.y = pk_bf16(v0[2], v0[3]); o.z = pk_bf16(v1[0], v1[1]); o.w = pk_bf16(v1[2], v1[3]);
                    *(u32x4*)(XB + off + bj * HALF) = o; }
                asm volatile("" ::: "memory"); }
    }
};
struct EpiF32 {
    float* C; int ldc;
    __device__ __forceinline__ void operator()(const f32x4 (&acc)[2][2][4][2], const Unit& u, int wr, int wc, int fr, int fq) const {
        const int row0 = u.pm * BM + wr * 64 + fr, col0 = u.pn * BM + wc * 32 + 8 * fq;
#pragma unroll
        for (int ai = 0; ai < 2; ++ai)
#pragma unroll
            for (int m = 0; m < 4; ++m) { float* rowp = C + (size_t)(row0 + ai * HALF + m * 16) * ldc + col0;
#pragma unroll
                for (int bj = 0; bj < 2; ++bj) { *(f32x4*)(rowp + bj * HALF) = acc[ai][bj][m][0]; *(f32x4*)(rowp + bj * HALF + 4) = acc[ai][bj][m][1]; } }
    }
};
}

struct Args { const float* in[26]; float* out; unsigned char* ws; int lo, hi; };
enum { I_X = 0, I_NMIX, I_NFFN, I_NFIN, I_WIN, I_WOUT, I_GCONV, I_GALOG, I_GDT, I_GNORM, I_HLB, I_HNORM, I_LCONVW, I_LCONVB, I_LWA, I_LBA, I_LWX, I_LBX, I_LLAM,
       I_DWG, I_DBG, I_DNORM, I_PWQ, I_PKEYS, I_PU, I_PV };
constexpr int NTHREADS = 512, NWAVES = 8;
constexpr int LDS_MISC = pg8::STAGE_BYTES;
constexpr int LDS_BYTES = pg8::STAGE_BYTES + 64;

__device__ __forceinline__ int win_srccol(int d) {
    if (d < 1536) return d;
    if (d < 3072) return d + 520;
    if (d < 3584) return d + 1032;
    if (d < 4608) return d + 1544;
    if (d < 5120) return d - 3072;
    if (d < 5632) return d - 1528;
    if (d < 6144) return d - 1016;
    if (d < 6656) return d + 8;
    if (d < 6664) return d - 4608;
    if (d < 6680) return d;
    return -1;
}
template <int MAP>
__device__ __forceinline__ void p0_transpose_item(const float* W, int K, int ldw, int nblk, bf16_t* WT, const float* rowscale, LAS float* scr, int item, int lane) {
    const int kb = item / nblk, nb = item % nblk, k0 = 64 * kb, n0 = 32 * nb;
    int sc = n0 + (lane & 31);
    if (MAP == 1) sc = win_srccol(sc);
#pragma unroll 8
    for (int i = 0; i < 32; ++i) { const int kk = 2 * i + (lane >> 5);
        float v = 0.f;
        if (sc >= 0) { v = W[(size_t)(k0 + kk) * ldw + sc]; if (rowscale) v *= rowscale[k0 + kk]; }
        scr[kk * 33 + (lane & 31)] = v; }
    asm volatile("s_waitcnt lgkmcnt(0)" ::: "memory");
    const int c = lane & 7;
#pragma unroll
    for (int j = 0; j < 4; ++j) { const int n = (lane >> 3) + 8 * j; const LAS float* s = scr + (8 * c) * 33 + n;
        u32x4 o; o.x = pk_bf16(s[0 * 33], s[1 * 33]); o.y = pk_bf16(s[2 * 33], s[3 * 33]); o.z = pk_bf16(s[4 * 33], s[5 * 33]); o.w = pk_bf16(s[6 * 33], s[7 * 33]);
        *(u32x4*)(WT + (size_t)(n0 + n) * K + k0 + 8 * c) = o; }
    asm volatile("s_waitcnt lgkmcnt(0)" ::: "memory");
}
__device__ __forceinline__ void convert_table(const float* src, bf16_t* dst, size_t n, int gtid, int gthreads) {
    const size_t n8 = n / 8;
    for (size_t i = gtid; i < n8; i += gthreads) { const f32x4 a = *(const f32x4*)(src + i * 8), b = *(const f32x4*)(src + i * 8 + 4);
        u32x4 o; o.x = pk_bf16(a[0], a[1]); o.y = pk_bf16(a[2], a[3]); o.z = pk_bf16(b[0], b[1]); o.w = pk_bf16(b[2], b[3]);
        *(u32x4*)(dst + i * 8) = o; }
}
__device__ __forceinline__ void p0_prologue(const Args& A, LAS unsigned char* lds) {
    const int tid = threadIdx.x, lane = tid & 63, wave = __builtin_amdgcn_readfirstlane(tid >> 6), G = gridDim.x, bx = blockIdx.x;
    const int gw = bx * NWAVES + wave, NGW = G * NWAVES;
    unsigned char* ws = A.ws;
    {
        float* X = A.out; bf16_t* XB = (bf16_t*)(ws + WS_XB); float* rstd1 = (float*)(ws + WS_RSTD1);
        for (int row = gw; row < MTOK; row += NGW) {
            const f32x4* xr = (const f32x4*)(A.in[I_X] + (size_t)row * DM) + lane; f32x4 v[4]; float s = 0.f;
#pragma unroll
            for (int j = 0; j < 4; ++j) { v[j] = xr[64 * j]; s += (v[j].x * v[j].x + v[j].y * v[j].y) + (v[j].z * v[j].z + v[j].w * v[j].w); }
            s = wave_sum64(s);
            f32x4* xo = (f32x4*)(X + (size_t)row * DM) + lane; u32x2* bo = (u32x2*)(XB + (size_t)row * DM) + lane;
#pragma unroll
            for (int j = 0; j < 4; ++j) { xo[64 * j] = v[j]; u32x2 o; o.x = pk_bf16(v[j].x, v[j].y); o.y = pk_bf16(v[j].z, v[j].w); bo[64 * j] = o; }
            if (lane == 0) rstd1[row] = rsqrtf(s * (1.f / DM) + EPS);
        }
    }
    {
        LAS float* scr = (LAS float*)(lds + wave * 8704);
        constexpr int NB_IN = NPROJP / 32, I_IN = (DM / 64) * NB_IN, NB_OUT = DM / 32, I_OUT = (2048 / 64) * NB_OUT;
        constexpr int NITEMS = NLAYER * (I_IN + I_OUT);
        for (int it = gw; it < NITEMS; it += NGW) {
            int r = it; const int l = r / (I_IN + I_OUT); r -= l * (I_IN + I_OUT);
            if (r < I_IN) p0_transpose_item<1>(A.in[I_WIN] + (size_t)l * DM * NPROJ, DM, NPROJ, NB_IN, (bf16_t*)(ws + WS_WIN) + (size_t)l * NPROJP * DM, A.in[I_NMIX] + l * DM, scr, r, lane);
            else p0_transpose_item<0>(A.in[I_WOUT] + (size_t)l * 2048 * DM, 2048, DM, NB_OUT, (bf16_t*)(ws + WS_WOUT) + (size_t)l * DM * 2048, nullptr, scr, r - I_IN, lane);
        }
    }
    __syncthreads();
    {
        LAS float* key_s = (LAS float*)lds; LAS float* wq_s = key_s + 128 * 129;
        for (int it = bx; it < NLAYER * 16 * 16; it += G) {
            const int l = it >> 8, hp = (it >> 4) & 15, k0 = (it & 15) * 64;
            const float* keys = A.in[I_PKEYS] + ((size_t)l * 16 + hp) * 128 * 128;
            const float* wq = A.in[I_PWQ] + (size_t)l * DM * 2048 + (size_t)k0 * 2048 + hp * 128;
            for (int e = tid; e < 128 * 128; e += NTHREADS) key_s[(e >> 7) * 129 + (e & 127)] = keys[e];
            for (int e = tid; e < 64 * 128; e += NTHREADS) wq_s[(e >> 7) * 129 + (e & 127)] = wq[(size_t)(e >> 7) * 2048 + (e & 127)];
            __syncthreads();
            const int ks = (tid & 15) * 4, ys = (tid >> 4) * 4;
            float acc[4][4];
#pragma unroll
            for (int i = 0; i < 4; ++i)
#pragma unroll
                for (int j = 0; j < 4; ++j) acc[i][j] = 0.f;
            for (int d = 0; d < 128; ++d) { float a[4], b[4];
#pragma unroll
                for (int i = 0; i < 4; ++i) { a[i] = wq_s[(ks + i) * 129 + d]; b[i] = key_s[(ys + i) * 129 + d]; }
#pragma unroll
                for (int i = 0; i < 4; ++i)
#pragma unroll
                    for (int j = 0; j < 4; ++j) acc[i][j] += a[i] * b[j]; }
            const float* nf = A.in[I_NFFN] + l * DM + k0 + ks;
            bf16_t* wt = (bf16_t*)(ws + WS_WEFF) + (size_t)l * 2048 * DM;
#pragma unroll
            for (int j = 0; j < 4; ++j) { u32x2 o; o.x = pk_bf16(acc[0][j] * nf[0], acc[1][j] * nf[1]); o.y = pk_bf16(acc[2][j] * nf[2], acc[3][j] * nf[3]);
                *(u32x2*)(wt + (size_t)(hp * 128 + ys + j) * DM + k0 + ks) = o; }
            __syncthreads();
        }
    }
    {
        bf16_t* wt = (bf16_t*)(ws + WS_LRUW);
        for (int e = bx * NTHREADS + tid; e < NLAYER * 2 * 4 * 128 * 128; e += G * NTHREADS) {
            const int k = e & 127, n = (e >> 7) & 127, g = (e >> 14) & 3, mat = (e >> 16) & 1, l = e >> 17;
            const float* src = A.in[mat ? I_LWX : I_LWA] + (((size_t)l * 4 + g) * 128 + k) * 128 + n;
            wt[e] = to_bf1(*src);
        }
    }
}

__device__ __forceinline__ void convert_tables(const Args& A, int l) {
    const int tid = threadIdx.x, lane = tid & 63, wave = __builtin_amdgcn_readfirstlane(tid >> 6), G = gridDim.x, bx = blockIdx.x;
    const int gw = bx * NWAVES + wave, NGW = G * NWAVES;
    unsigned char* ws = A.ws;
    for (int row = gw; row < 2 * 16384; row += NGW) {
        const int tbl = row >> 14, rr = row & 16383;
        const float* src = A.in[tbl ? I_PV : I_PU] + ((size_t)l * 16384 + rr) * DM + 16 * lane;
        f32x4 v[4]; float mx = 0.f;
#pragma unroll
        for (int j = 0; j < 4; ++j) { v[j] = *(const f32x4*)(src + 4 * j); mx = fmaxf(fmaxf(mx, fmaxf(fabsf(v[j].x), fabsf(v[j].y))), fmaxf(fabsf(v[j].z), fabsf(v[j].w))); }
        mx = fmaxf(mx, dpp_f<0x128>(mx)); mx = fmaxf(mx, dpp_f<0x124>(mx)); mx = fmaxf(mx, dpp_f<0x122>(mx)); mx = fmaxf(mx, dpp_f<0x121>(mx));
        mx = fmaxf(fmaxf(rdlane(mx, 0), rdlane(mx, 16)), fmaxf(rdlane(mx, 32), rdlane(mx, 48)));
        mx = fmaxf(mx, 1e-30f);
        const float sc = 224.f / mx;
        u32x4 o; int p;
        p = 0; p = __builtin_amdgcn_cvt_pk_fp8_f32(v[0].x * sc, v[0].y * sc, p, false); p = __builtin_amdgcn_cvt_pk_fp8_f32(v[0].z * sc, v[0].w * sc, p, true); o.x = (unsigned)p;
        p = 0; p = __builtin_amdgcn_cvt_pk_fp8_f32(v[1].x * sc, v[1].y * sc, p, false); p = __builtin_amdgcn_cvt_pk_fp8_f32(v[1].z * sc, v[1].w * sc, p, true); o.y = (unsigned)p;
        p = 0; p = __builtin_amdgcn_cvt_pk_fp8_f32(v[2].x * sc, v[2].y * sc, p, false); p = __builtin_amdgcn_cvt_pk_fp8_f32(v[2].z * sc, v[2].w * sc, p, true); o.z = (unsigned)p;
        p = 0; p = __builtin_amdgcn_cvt_pk_fp8_f32(v[3].x * sc, v[3].y * sc, p, false); p = __builtin_amdgcn_cvt_pk_fp8_f32(v[3].z * sc, v[3].w * sc, p, true); o.w = (unsigned)p;
        *(u32x4*)(ws + (tbl ? WS_V8 : WS_U8) + (size_t)rr * DM + 16 * lane) = o;
        if (lane == 0) ((float*)(ws + (tbl ? WS_SV : WS_SU)))[rr] = mx * (1.f / 224.f);
    }
}

__device__ __forceinline__ void load8(const bf16_t* p, float (&f)[8]) { unpack8(*(const u32x4*)p, f); }
__device__ __forceinline__ float hgrn_lb(const Args& A, int l, int c) {
    if (l == 0) return 0.f;
    const float* lg = A.in[I_HLB]; return sigmoidf_(lg[512 + c] - lg[c]);
}
typedef bf16x8 frag_t;
#define MFMA16(a_, b_, c_) __builtin_amdgcn_mfma_f32_16x16x32_bf16((a_), (b_), (c_), 0, 0, 0)
constexpr int XCS = 520;
constexpr int P136 = 136, P72 = 72, P68 = 68;
constexpr int LDS_SMALL = 122880;
template <int DK>
__device__ __forceinline__ void k1_gla_head(const Args& A, LAS unsigned char* lds, int l, int h, int r0, int ci, bf16_t* proj, unsigned char* aux) {
    constexpr bool HG = (DK == 128);
    constexpr int NSEG = NTHREADS / DK, TPS = 64 / NSEG, PD = DK + 8;
    const int tid = threadIdx.x, lane = tid & 63, wave = __builtin_amdgcn_readfirstlane(tid >> 6), c = tid % DK, seg = tid / DK;
    LAS bf16_t* Q1L = (LAS bf16_t*)lds; LAS bf16_t* K1L = Q1L + 64 * PD; LAS float* segsum = (LAS float*)(K1L + 64 * PD);
    const int qcol = (HG ? C_BQ : C_DQ) + h * DK + c, kcol = (HG ? C_BF : C_DK) + h * DK + c;
    float lbv = 0.f, wg[16], bgv = 0.f;
    if (HG) lbv = hgrn_lb(A, l, h * 128 + c);
    else { const float* wgp = A.in[I_DWG] + (size_t)l * 16 * 256 + h * 64 + c;
#pragma unroll
        for (int r = 0; r < 16; ++r) wg[r] = wgp[r * 256];
        bgv = A.in[I_DBG][l * 256 + h * 64 + c]; }
#define K1_TOKEN(row_, qv_, kv_, lg_) do { const bf16_t* pr_ = proj + (size_t)(row_) * NPROJ; const float qr_ = bf1(pr_[qcol]), kr_ = bf1(pr_[kcol]); \
        if (HG) { qv_ = siluf_(qr_); kv_ = (1.f - lbv) * sigmoidf_(-kr_); lg_ = log1pf(-kv_); } \
        else { qv_ = qr_; kv_ = kr_; float t8_[8]; float z_ = bgv; load8(pr_ + C_DLR, t8_); \
            _Pragma("unroll") for (int r_ = 0; r_ < 8; ++r_) z_ = fmaf(t8_[r_], wg[r_], z_); \
            load8(pr_ + C_DLR + 8, t8_); \
            _Pragma("unroll") for (int r_ = 0; r_ < 8; ++r_) z_ = fmaf(t8_[r_], wg[8 + r_], z_); \
            lg_ = -softplusf_(-z_) * (1.f / 16.f); } } while (0)
    {
        float run = 0.f;
#pragma unroll 2
        for (int i = 0; i < TPS; ++i) { float qv, kv, lg; K1_TOKEN(r0 + seg * TPS + i, qv, kv, lg); run += lg; asm volatile("" :: "v"(qv), "v"(kv)); }
        segsum[seg * DK + c] = run;
    }
    __syncthreads();
    float off = 0.f, bref = 0.f, blast = 0.f;
#pragma unroll
    for (int s2 = 0; s2 < NSEG; ++s2) { const float v = segsum[s2 * DK + c]; if (s2 < seg) off += v; if (s2 < NSEG / 2) bref += v; blast += v; }
    {
        bf16_t* ktp = (bf16_t*)(aux + (HG ? AX_HKT : AX_DKT)) + ((size_t)ci * DK + c) * 64 + seg * TPS;
        float run = off;
#pragma unroll 1
        for (int i8 = 0; i8 < TPS; i8 += 8) { float k2[8];
#pragma unroll
            for (int i = 0; i < 8; ++i) { const int t = seg * TPS + i8 + i; float qv, kv, lg; K1_TOKEN(r0 + t, qv, kv, lg); run += lg; const float b = run;
                Q1L[t * PD + c] = to_bf1(qv * __expf(b - bref)); K1L[t * PD + c] = to_bf1(kv * __expf(bref - b));
                proj[(size_t)(r0 + t) * NPROJ + qcol] = to_bf1(qv * __expf(b));
                k2[i] = kv * __expf(blast - b); }
            u32x4 o; o.x = pk_bf16(k2[0], k2[1]); o.y = pk_bf16(k2[2], k2[3]); o.z = pk_bf16(k2[4], k2[5]); o.w = pk_bf16(k2[6], k2[7]); *(u32x4*)(ktp + i8) = o; }
        if (seg == 0) ((float*)(aux + (HG ? AX_HGD : AX_DGD)))[(size_t)ci * DK + c] = __expf(blast);
    }
#undef K1_TOKEN
    __syncthreads();
    {
        const int fr = lane & 15, fq = lane >> 4;
        bf16_t* att = (bf16_t*)(aux + (HG ? AX_HATT : AX_DATT)) + (size_t)ci * 64 * 64;
#pragma unroll
        for (int tt = 0; tt < 2; ++tt) { const int id = wave * 2 + tt, mi = id >> 2, nj = id & 3;
            f32x4 acc = {0.f, 0.f, 0.f, 0.f};
            if (nj <= mi) {
#pragma unroll
                for (int ks = 0; ks < DK / 32; ++ks) { const frag_t a = *(const LAS frag_t*)(Q1L + (mi * 16 + fr) * PD + ks * 32 + fq * 8), b = *(const LAS frag_t*)(K1L + (nj * 16 + fr) * PD + ks * 32 + fq * 8);
                    acc = MFMA16(a, b, acc); } }
#pragma unroll
            for (int r = 0; r < 4; ++r) { const int i = mi * 16 + fq * 4 + r, j = nj * 16 + fr; att[i * 64 + j] = to_bf1(j <= i ? acc[r] : 0.f); } }
    }
    __syncthreads();
}
__device__ __forceinline__ void b1_prep(const Args& A, LAS unsigned char* lds, int l, int half) {
    const int tid = threadIdx.x, lane = tid & 63, wave = __builtin_amdgcn_readfirstlane(tid >> 6), G = gridDim.x, fr = lane & 15, fq = lane >> 4;
    bf16_t* proj = (bf16_t*)(A.ws + WS_PROJ); unsigned char* aux = A.ws + WS_AUX;
    LAS bf16_t* xc = (LAS bf16_t*)lds;
    LAS float* sg = (LAS float*)(lds + LDS_SMALL);
    LAS float* sb = sg + 256;
    LAS float* sgc = sb + 256;
    for (int tile = blockIdx.x; tile < HM / 64; tile += G) {
        const int r0 = tile * 64, t0 = (tile & 63) * 64, bb = tile >> 6, chunk = tile & 63;
        for (int u = wave; u < 24; u += NWAVES) {
            const int p = u >> 3, ch = u & 7, c = p * 512 + lane * 8, ts = t0 + ch * 8, rs = r0 + ch * 8;
            const float* cwp = A.in[I_GCONV] + (size_t)l * 4 * 1536 + c;
            float cw[4][8];
#pragma unroll
            for (int w = 0; w < 4; ++w) { const f32x4 a = *(const f32x4*)(cwp + w * 1536), b = *(const f32x4*)(cwp + w * 1536 + 4);
                cw[w][0] = a[0]; cw[w][1] = a[1]; cw[w][2] = a[2]; cw[w][3] = a[3]; cw[w][4] = b[0]; cw[w][5] = b[1]; cw[w][6] = b[2]; cw[w][7] = b[3]; }
            float x3[8], x2[8], x1[8], x0[8];
            if (ts >= 3) { load8(proj + (size_t)(rs - 3) * NPROJ + c, x3); load8(proj + (size_t)(rs - 2) * NPROJ + c, x2); load8(proj + (size_t)(rs - 1) * NPROJ + c, x1); }
            else {
#pragma unroll
                for (int j = 0; j < 8; ++j) { x3[j] = 0.f; x2[j] = 0.f; x1[j] = 0.f; } }
            const int ci = (bb * 4 + (lane >> 4)) * 64 + chunk;
            bf16_t* dst = (bf16_t*)(aux + (p == 0 ? AX_GQ : (p == 1 ? AX_GW : AX_GO))) + ((size_t)ci * 64 + ch * 8) * 128 + (lane & 15) * 8;
#pragma unroll
            for (int i = 0; i < 8; ++i) {
                load8(proj + (size_t)(rs + i) * NPROJ + c, x0);
                float o[8]; float ss = 0.f;
#pragma unroll
                for (int j = 0; j < 8; ++j) { const float v = cw[0][j] * x3[j] + cw[1][j] * x2[j] + cw[2][j] * x1[j] + cw[3][j] * x0[j]; o[j] = siluf_(v); ss += o[j] * o[j]; }
                if (p < 2) { ss = row_sum16(ss); const float sc = rsqrtf(ss + EPS);
#pragma unroll
                    for (int j = 0; j < 8; ++j) o[j] *= sc; }
                *(u32x4*)(dst + (size_t)i * 128) = pack8(o);
#pragma unroll
                for (int j = 0; j < 8; ++j) { x3[j] = x2[j]; x2[j] = x1[j]; x1[j] = x0[j]; }
            }
        }
        if (tid < 256) { const int tk = tid & 63, h = tid >> 6; const size_t row = (size_t)(r0 + tk);
            const float a = bf1(proj[row * NPROJ + C_AA + h]), b = bf1(proj[row * NPROJ + C_AB + h]);
            sg[h * 64 + tk] = -__expf(A.in[I_GALOG][l * 4 + h]) * softplusf_(a + A.in[I_GDT][l * 4 + h]); sb[h * 64 + tk] = sigmoidf_(b); }
        { const int ch = wave, c = lane * 8, ts = t0 + ch * 8, rs = r0 + ch * 8;
            const float* cwp = A.in[I_LCONVW] + (size_t)l * 4 * 512 + c; const float* cbp = A.in[I_LCONVB] + l * 512 + c;
            float cw[4][8], cb[8];
#pragma unroll
            for (int w = 0; w < 4; ++w) { const f32x4 a = *(const f32x4*)(cwp + w * 512), b = *(const f32x4*)(cwp + w * 512 + 4);
                cw[w][0] = a[0]; cw[w][1] = a[1]; cw[w][2] = a[2]; cw[w][3] = a[3]; cw[w][4] = b[0]; cw[w][5] = b[1]; cw[w][6] = b[2]; cw[w][7] = b[3]; }
            { const f32x4 a = *(const f32x4*)cbp, b = *(const f32x4*)(cbp + 4); cb[0] = a[0]; cb[1] = a[1]; cb[2] = a[2]; cb[3] = a[3]; cb[4] = b[0]; cb[5] = b[1]; cb[6] = b[2]; cb[7] = b[3]; }
            float x3[8], x2[8], x1[8], x0[8];
            const bf16_t* src = proj + C_CX + c;
            if (ts >= 3) { load8(src + (size_t)(rs - 3) * NPROJ, x3); load8(src + (size_t)(rs - 2) * NPROJ, x2); load8(src + (size_t)(rs - 1) * NPROJ, x1); }
            else {
#pragma unroll
                for (int j = 0; j < 8; ++j) { x3[j] = 0.f; x2[j] = 0.f; x1[j] = 0.f; } }
#pragma unroll
            for (int i = 0; i < 8; ++i) {
                load8(src + (size_t)(rs + i) * NPROJ, x0);
                float o[8];
#pragma unroll
                for (int j = 0; j < 8; ++j) o[j] = cb[j] + cw[0][j] * x3[j] + cw[1][j] * x2[j] + cw[2][j] * x1[j] + cw[3][j] * x0[j];
                *(LAS u32x4*)(xc + (ch * 8 + i) * XCS + c) = pack8(o);
#pragma unroll
                for (int j = 0; j < 8; ++j) { x3[j] = x2[j]; x2[j] = x1[j]; x1[j] = x0[j]; }
            }
        }
        __syncthreads();
        { const int g = wave >> 1, nh = wave & 1;
            const bf16_t* wa = (const bf16_t*)(A.ws + WS_LRUW) + (((size_t)l * 2 + 0) * 4 + g) * 128 * 128;
            const bf16_t* wx = (const bf16_t*)(A.ws + WS_LRUW) + (((size_t)l * 2 + 1) * 4 + g) * 128 * 128;
            bf16_t* lom = (bf16_t*)(aux + AX_LOM); bf16_t* lbb = (bf16_t*)(aux + AX_LB);
#pragma unroll 1
            for (int nt = 0; nt < 4; ++nt) {
                const int n = nh * 64 + nt * 16 + fr, cch = g * 128 + n;
                frag_t ba[4], bx[4];
#pragma unroll
                for (int ks = 0; ks < 4; ++ks) { ba[ks] = *(const frag_t*)(wa + (size_t)n * 128 + ks * 32 + fq * 8); bx[ks] = *(const frag_t*)(wx + (size_t)n * 128 + ks * 32 + fq * 8); }
                const float b_a = A.in[I_LBA][l * 512 + cch], b_x = A.in[I_LBX][l * 512 + cch], spl = softplusf_(-A.in[I_LLAM][l * 512 + cch]);
#pragma unroll 1
                for (int m = 0; m < 4; ++m) {
                    f32x4 ca = {0.f, 0.f, 0.f, 0.f}, cx = {0.f, 0.f, 0.f, 0.f};
#pragma unroll
                    for (int ks = 0; ks < 4; ++ks) { const frag_t af = *(const LAS frag_t*)(xc + (m * 16 + fr) * XCS + g * 128 + ks * 32 + fq * 8);
                        ca = MFMA16(af, ba[ks], ca); cx = MFMA16(af, bx[ks], cx); }
#pragma unroll
                    for (int j = 0; j < 4; ++j) { const int tk = m * 16 + fq * 4 + j;
                        const float r = sigmoidf_(ca[j] + b_a), ig = sigmoidf_(cx[j] + b_x), la = -8.f * r * spl;
                        const float om = -expm1f(la), mult = sqrtf(-expm1f(2.f * la)), xv = bf1(xc[tk * XCS + cch]);
                        lom[(size_t)(r0 + tk) * 512 + cch] = to_bf1(om); lbb[(size_t)(r0 + tk) * 512 + cch] = to_bf1(mult * ig * xv); }
                }
            }
        }
        __syncthreads();
        for (int h = 0; h < 4; ++h) k1_gla_head<128>(A, lds, l, h, r0, (bb * 4 + h) * 64 + chunk, proj, aux);
        for (int h = 0; h < 4; ++h) k1_gla_head<64>(A, lds, l, h, r0, (bb * 4 + h) * 64 + chunk, proj, aux);
        LAS bf16_t* kL = (LAS bf16_t*)lds;
        LAS bf16_t* qL = kL + 64 * P136;
        LAS float* AL = (LAS float*)(lds + 36864);
        float gcv = 0.f;
        if (tid < 256) { const int tk = tid & 63, h = tid >> 6;
            for (int s2 = 0; s2 < 64; ++s2) { const float v = sg[h * 64 + s2]; gcv += (s2 <= tk) ? v : 0.f; } }
        __syncthreads();
        if (tid < 256) sg[tid] = gcv;
        __syncthreads();
        for (int h = 0; h < 4; ++h) {
            const int ci = (bb * 4 + h) * 64 + chunk;
            bf16_t* gq = (bf16_t*)(aux + AX_GQ) + (size_t)ci * 64 * 128; const bf16_t* gk = (const bf16_t*)(aux + AX_GW) + (size_t)ci * 64 * 128;
            bf16_t* gkt = (bf16_t*)(aux + AX_GKT) + (size_t)ci * 128 * 64;
            const float glast = sg[h * 64 + 63];
#pragma unroll
            for (int e2 = 0; e2 < 2; ++e2) { const int e = tid + e2 * NTHREADS, t = e & 63, dc = (e >> 6) * 8; const float gct = sg[h * 64 + t];
                const u32x4 kr = *(const u32x4*)(gk + t * 128 + dc), qr = *(const u32x4*)(gq + t * 128 + dc);
                *(LAS u32x4*)(kL + t * P136 + dc) = kr; *(LAS u32x4*)(qL + t * P136 + dc) = qr;
                float kf[8], qf[8]; unpack8(kr, kf); unpack8(qr, qf);
                const float eg = __expf(gct), ek = __expf(glast - gct);
#pragma unroll
                for (int j = 0; j < 8; ++j) { gkt[(dc + j) * 64 + t] = to_bf1(kf[j] * ek); qf[j] *= eg; }
                *(u32x4*)(gq + t * 128 + dc) = pack8(qf); }
            if (tid == 0) ((float*)(aux + AX_GGL))[ci] = __expf(glast);
            __syncthreads();
            { bf16_t* gqk = (bf16_t*)(aux + AX_GQK) + (size_t)ci * 64 * 64; LAS float* ALh = AL + h * 64 * P68;
#pragma unroll
                for (int tt = 0; tt < 2; ++tt) { const int id = wave * 2 + tt, mi = id >> 2, nj = id & 3;
                    f32x4 ak = {0.f, 0.f, 0.f, 0.f}, aq = {0.f, 0.f, 0.f, 0.f};
                    if (nj <= mi) {
#pragma unroll
                        for (int ks = 0; ks < 4; ++ks) { const frag_t ka = *(const LAS frag_t*)(kL + (mi * 16 + fr) * P136 + ks * 32 + fq * 8), qa = *(const LAS frag_t*)(qL + (mi * 16 + fr) * P136 + ks * 32 + fq * 8),
                                kb = *(const LAS frag_t*)(kL + (nj * 16 + fr) * P136 + ks * 32 + fq * 8);
                            ak = MFMA16(ka, kb, ak); aq = MFMA16(qa, kb, aq); } }
                    const int j = nj * 16 + fr; const float gj = sg[h * 64 + j];
#pragma unroll
                    for (int r = 0; r < 4; ++r) { const int i = mi * 16 + fq * 4 + r; const float dec = __expf(fminf(sg[h * 64 + i] - gj, 0.f));
                        ALh[i * P68 + j] = (j < i) ? sb[h * 64 + i] * ak[r] * dec : 0.f;
                        gqk[i * 64 + j] = to_bf1(j <= i ? aq[r] * dec : 0.f); } }
            }
            __syncthreads();
        }
        if (wave < 4) { LAS float* ALh = AL + wave * 64 * P68;
            float T[64];
#pragma unroll
            for (int i = 0; i < 64; ++i) { int li = lane; asm volatile("" : "+v"(li)); float a0 = (li == i) ? 1.f : 0.f, a1 = 0.f;
#pragma unroll
                for (int m4 = 0; m4 < i; m4 += 4) { const f32x4 av = *(const LAS f32x4*)(ALh + i * P68 + m4);
                    a0 = fmaf(-av[0], T[m4], a0);
                    if (m4 + 1 < i) a1 = fmaf(-av[1], T[m4 + 1], a1);
                    if (m4 + 2 < i) a0 = fmaf(-av[2], T[m4 + 2], a0);
                    if (m4 + 3 < i) a1 = fmaf(-av[3], T[m4 + 3], a1); }
                T[i] = a0 + a1; }
            asm volatile("s_waitcnt lgkmcnt(0)" ::: "memory");
            LAS bf16_t* TLh = (LAS bf16_t*)ALh;
#pragma unroll
            for (int i = 0; i < 64; ++i) TLh[i * P72 + lane] = to_bf1(T[i]);
        }
        __syncthreads();
        LAS bf16_t* XT = kL; LAS bf16_t* VT = XT + 128 * P72;
        for (int h = 0; h < 4; ++h) {
            const int ci = (bb * 4 + h) * 64 + chunk;
            bf16_t* gw = (bf16_t*)(aux + AX_GW) + (size_t)ci * 64 * 128; const bf16_t* gv = (const bf16_t*)(aux + AX_GO) + (size_t)ci * 64 * 128;
            bf16_t* gut = (bf16_t*)(aux + AX_GUT) + (size_t)ci * 128 * 64;
#pragma unroll
            for (int e2 = 0; e2 < 2; ++e2) { const int e = tid + e2 * NTHREADS, t = e & 63, dc = (e >> 6) * 8; const float bt = sb[h * 64 + t], bx = bt * __expf(sg[h * 64 + t]);
                float kf[8], vf[8]; load8(gw + t * 128 + dc, kf); load8(gv + t * 128 + dc, vf);
#pragma unroll
                for (int j = 0; j < 8; ++j) { XT[(dc + j) * P72 + t] = to_bf1(kf[j] * bx); VT[(dc + j) * P72 + t] = to_bf1(vf[j] * bt); } }
            __syncthreads();
            { const LAS bf16_t* TLh = (const LAS bf16_t*)(AL + h * 64 * P68);
#pragma unroll 1
                for (int tt = 0; tt < 4; ++tt) { const int id = wave * 4 + tt, mi = id >> 3, nd = id & 7;
                    f32x4 aw = {0.f, 0.f, 0.f, 0.f}, au = {0.f, 0.f, 0.f, 0.f};
#pragma unroll
                    for (int ks = 0; ks < 2; ++ks) { const frag_t ta = *(const LAS frag_t*)(TLh + (mi * 16 + fr) * P72 + ks * 32 + fq * 8), xb = *(const LAS frag_t*)(XT + (nd * 16 + fr) * P72 + ks * 32 + fq * 8),
                            vb = *(const LAS frag_t*)(VT + (nd * 16 + fr) * P72 + ks * 32 + fq * 8);
                        aw = MFMA16(ta, xb, aw); au = MFMA16(ta, vb, au); }
#pragma unroll
                    for (int r = 0; r < 4; ++r) gw[(mi * 16 + fq * 4 + r) * 128 + nd * 16 + fr] = to_bf1(aw[r]);
                    u32x2 o; o.x = pk_bf16(au[0], au[1]); o.y = pk_bf16(au[2], au[3]);
                    *(u32x2*)(gut + (nd * 16 + fr) * 64 + mi * 16 + fq * 4) = o; }
            }
            __syncthreads();
        }
    }
}

template <bool DELTA, int DK>
__device__ __forceinline__ void k2_unit(LAS unsigned char* lds, unsigned char* aux, bf16_t* proj, int bbh) {
    constexpr int PD = DK + 8, MT = DK / 16, KS = DK / 32;
    constexpr bool HG = (DK == 128);
    const int tid = threadIdx.x, lane = tid & 63, wave = __builtin_amdgcn_readfirstlane(tid >> 6), fr = lane & 15, fq = lane >> 4;
    LAS bf16_t* sA1 = (LAS bf16_t*)lds;
    LAS bf16_t* sA2 = sA1 + 64 * PD;
    constexpr int PD2 = DELTA ? PD : P136;
    LAS bf16_t* sKT = sA2 + 64 * PD2;
    LAS bf16_t* sAT = sKT + DK * P72;
    LAS float* sGD = (LAS float*)(sAT + 64 * P72);
    LAS bf16_t* pS = (LAS bf16_t*)(sGD + 128) + (wave & 3) * (32 * PD + 32 * P72);
    LAS bf16_t* pX = pS + 32 * PD;
    const int bb = bbh >> 2, h = bbh & 3;
    const size_t ci0 = (size_t)bbh * 64;
    const bf16_t* gA1; const bf16_t* gA2; const bf16_t* gKT; const bf16_t* gAT; const float* gGD; size_t a1ld, a2ld, a1cs, a2cs;
    if (DELTA) { gA1 = (const bf16_t*)(aux + AX_GW) + ci0 * 8192; gA2 = (const bf16_t*)(aux + AX_GQ) + ci0 * 8192; a1ld = 128; a2ld = 128; a1cs = 8192; a2cs = 8192;
        gKT = (const bf16_t*)(aux + AX_GKT) + ci0 * 8192; gAT = (const bf16_t*)(aux + AX_GQK) + ci0 * 4096; gGD = (const float*)(aux + AX_GGL) + ci0; }
    else { gA1 = proj + (size_t)bb * SEQ * NPROJ + (HG ? C_BQ : C_DQ) + h * DK; gA2 = proj + (size_t)bb * SEQ * NPROJ + (HG ? C_BI : C_DV) + h * 128; a1ld = NPROJ; a2ld = NPROJ; a1cs = (size_t)64 * NPROJ; a2cs = (size_t)64 * NPROJ;
        gKT = (const bf16_t*)(aux + (HG ? AX_HKT : AX_DKT)) + ci0 * DK * 64; gAT = (const bf16_t*)(aux + (HG ? AX_HATT : AX_DATT)) + ci0 * 4096; gGD = (const float*)(aux + (HG ? AX_HGD : AX_DGD)) + ci0 * DK; }
    constexpr int N1 = 64 * DK / 8 / 256, N2 = DELTA ? N1 : 4, NK = DK * 8 / 256, NA = 2;
    u32x4 r1[N1], r2[N2], rk[NK], ra[NA]; float rg = 0.f;
    const int st = tid - 256;
#define K2_GLOAD(c_) do { if (wave >= 4) { \
        _Pragma("unroll") for (int i = 0; i < N1; ++i) { const int e = st + i * 256, r = e / (DK / 8), cc = (e % (DK / 8)) * 8; r1[i] = *(const u32x4*)(gA1 + (size_t)(c_) * a1cs + (size_t)r * a1ld + cc); } \
        _Pragma("unroll") for (int i = 0; i < N2; ++i) { const int e = st + i * 256, r = DELTA ? e / (DK / 8) : e / 16, cc = (DELTA ? e % (DK / 8) : e % 16) * 8; r2[i] = *(const u32x4*)(gA2 + (size_t)(c_) * a2cs + (size_t)r * a2ld + cc); } \
        _Pragma("unroll") for (int i = 0; i < NK; ++i) { const int e = st + i * 256; rk[i] = *(const u32x4*)(gKT + (size_t)(c_) * DK * 64 + (size_t)e * 8); } \
        _Pragma("unroll") for (int i = 0; i < NA; ++i) { const int e = st + i * 256; ra[i] = *(const u32x4*)(gAT + (size_t)(c_) * 4096 + (size_t)e * 8); } \
        if (DELTA) { if (st == 0) rg = gGD[(c_)]; } else { if (st < DK) rg = gGD[(size_t)(c_) * DK + st]; } } } while (0)
#define K2_LSTORE() do { if (wave >= 4) { \
        _Pragma("unroll") for (int i = 0; i < N1; ++i) { const int e = st + i * 256, r = e / (DK / 8), cc = (e % (DK / 8)) * 8; *(LAS u32x4*)(sA1 + r * PD + cc) = r1[i]; } \
        _Pragma("unroll") for (int i = 0; i < N2; ++i) { const int e = st + i * 256, r = DELTA ? e / (DK / 8) : e / 16, cc = (DELTA ? e % (DK / 8) : e % 16) * 8; *(LAS u32x4*)(sA2 + r * PD2 + cc) = r2[i]; } \
        _Pragma("unroll") for (int i = 0; i < NK; ++i) { const int e = st + i * 256, r = e / 8, cc = (e % 8) * 8; *(LAS u32x4*)(sKT + r * P72 + cc) = rk[i]; } \
        _Pragma("unroll") for (int i = 0; i < NA; ++i) { const int e = st + i * 256, r = e / 8, cc = (e % 8) * 8; *(LAS u32x4*)(sAT + r * P72 + cc) = ra[i]; } \
        if (DELTA) { if (st == 0) sGD[0] = rg; } else { if (st < DK) sGD[st] = rg; } } } while (0)
    f32x4 accS[MT][2];
#pragma unroll
    for (int m = 0; m < MT; ++m) { accS[m][0] = (f32x4){0.f, 0.f, 0.f, 0.f}; accS[m][1] = (f32x4){0.f, 0.f, 0.f, 0.f}; }
    const int dv0 = wave * 32;
    const bf16_t* gUT = (const bf16_t*)(aux + AX_GUT) + ci0 * 8192;
    bf16_t* gO = DELTA ? (bf16_t*)(aux + AX_GO) + ci0 * 8192 : proj + (size_t)bb * SEQ * NPROJ + (HG ? C_BI : C_DV) + h * 128;
    const size_t old = DELTA ? 128 : NPROJ, ocs = DELTA ? 8192 : (size_t)64 * NPROJ;
    u32x2 ru[4][2];
#define K2_ULOAD(c_) do { if (DELTA && wave < 4) { _Pragma("unroll") for (int m = 0; m < 4; ++m) _Pragma("unroll") for (int nt = 0; nt < 2; ++nt) \
        ru[m][nt] = *(const u32x2*)(gUT + (size_t)(c_) * 8192 + (size_t)(dv0 + nt * 16 + fr) * 64 + m * 16 + fq * 4); } } while (0)
    K2_GLOAD(0); K2_LSTORE(); K2_ULOAD(0);
    __syncthreads();
    if (wave >= 4) {
        for (int c = 0; c < 64; ++c) {
            if (c + 1 < 64) K2_GLOAD(c + 1);
            __syncthreads();
            if (c + 1 < 64) K2_LSTORE();
            __syncthreads();
        }
    } else
    for (int c = 0; c < 64; ++c) {
        {
#pragma unroll
            for (int m = 0; m < MT; ++m)
#pragma unroll
                for (int nt = 0; nt < 2; ++nt) { u32x2 o; o.x = pk_bf16(accS[m][nt][0], accS[m][nt][1]); o.y = pk_bf16(accS[m][nt][2], accS[m][nt][3]);
                    *(LAS u32x2*)(pS + (nt * 16 + fr) * PD + m * 16 + fq * 4) = o; }
            asm volatile("s_waitcnt lgkmcnt(0)" ::: "memory");
#define K2_BS(ks_, nt_) (*(const LAS frag_t*)(pS + ((nt_) * 16 + fr) * PD + (ks_) * 32 + fq * 8))
            frag_t bX[2][2];
            if (DELTA) {
                f32x4 accV[4][2];
#pragma unroll
                for (int m = 0; m < 4; ++m)
#pragma unroll
                    for (int nt = 0; nt < 2; ++nt) { accV[m][nt][0] = -bf_lo(ru[m][nt].x); accV[m][nt][1] = -bf_hi(ru[m][nt].x); accV[m][nt][2] = -bf_lo(ru[m][nt].y); accV[m][nt][3] = -bf_hi(ru[m][nt].y); }
                if (c + 1 < 64) K2_ULOAD(c + 1);
#pragma unroll
                for (int ks = 0; ks < KS; ++ks)
#pragma unroll
                    for (int m = 0; m < 4; ++m) { const frag_t a = *(const LAS frag_t*)(sA1 + (m * 16 + fr) * PD + ks * 32 + fq * 8);
                        accV[m][0] = MFMA16(a, K2_BS(ks, 0), accV[m][0]); accV[m][1] = MFMA16(a, K2_BS(ks, 1), accV[m][1]); __builtin_amdgcn_sched_barrier(0); }
#pragma unroll
                for (int m = 0; m < 4; ++m)
#pragma unroll
                    for (int nt = 0; nt < 2; ++nt) { u32x2 o; o.x = pk_bf16(-accV[m][nt][0], -accV[m][nt][1]); o.y = pk_bf16(-accV[m][nt][2], -accV[m][nt][3]);
                        *(LAS u32x2*)(pX + (nt * 16 + fr) * P72 + m * 16 + fq * 4) = o; }
                asm volatile("s_waitcnt lgkmcnt(0)" ::: "memory");
#pragma unroll
                for (int ks = 0; ks < 2; ++ks)
#pragma unroll
                    for (int nt = 0; nt < 2; ++nt) bX[ks][nt] = *(const LAS frag_t*)(pX + (nt * 16 + fr) * P72 + ks * 32 + fq * 8);
            } else {
#pragma unroll
                for (int ks = 0; ks < 2; ++ks)
#pragma unroll
                    for (int nt = 0; nt < 2; ++nt) { const LAS bf16_t* vp = sA2 + (ks * 32 + fq * 8) * PD2 + dv0 + nt * 16 + fr;
                        frag_t f;
#pragma unroll
                        for (int j = 0; j < 8; ++j) f[j] = (short)vp[j * PD2];
                        bX[ks][nt] = f; }
            }
            __builtin_amdgcn_sched_barrier(0);
            {
                const LAS bf16_t* sQ = DELTA ? sA2 : sA1; constexpr int PQ = DELTA ? PD2 : PD;
#pragma unroll 1
                for (int m = 0; m < 4; ++m) { f32x4 o0 = {0.f, 0.f, 0.f, 0.f}, o1 = {0.f, 0.f, 0.f, 0.f};
#pragma unroll
                    for (int ks = 0; ks < KS; ++ks) { const frag_t a = *(const LAS frag_t*)(sQ + (m * 16 + fr) * PQ + ks * 32 + fq * 8); o0 = MFMA16(a, K2_BS(ks, 0), o0); o1 = MFMA16(a, K2_BS(ks, 1), o1); __builtin_amdgcn_sched_barrier(0); }
#pragma unroll
                    for (int ks = 0; ks < 2; ++ks) { const frag_t a = *(const LAS frag_t*)(sAT + (m * 16 + fr) * P72 + ks * 32 + fq * 8); o0 = MFMA16(a, bX[ks][0], o0); o1 = MFMA16(a, bX[ks][1], o1); __builtin_amdgcn_sched_barrier(0); }
                    bf16_t* op = gO + (size_t)c * ocs + (size_t)(m * 16 + fq * 4) * old + dv0 + fr;
#pragma unroll
                    for (int r = 0; r < 4; ++r) { op[(size_t)r * old] = to_bf1(o0[r]); op[(size_t)r * old + 16] = to_bf1(o1[r]); } }
            }
            __builtin_amdgcn_sched_barrier(0);
            if (DELTA) { const float gl = sGD[0];
#pragma unroll
                for (int m = 0; m < MT; ++m) { accS[m][0] *= gl; accS[m][1] *= gl; } }
            else {
#pragma unroll
                for (int m = 0; m < MT; ++m) { const f32x4 gd = *(const LAS f32x4*)(sGD + m * 16 + fq * 4); accS[m][0] *= gd; accS[m][1] *= gd; } }
#pragma unroll
            for (int ks = 0; ks < 2; ++ks)
#pragma unroll
                for (int m = 0; m < MT; ++m) { const frag_t a = *(const LAS frag_t*)(sKT + (m * 16 + fr) * P72 + ks * 32 + fq * 8);
                    accS[m][0] = MFMA16(a, bX[ks][0], accS[m][0]); accS[m][1] = MFMA16(a, bX[ks][1], accS[m][1]); __builtin_amdgcn_sched_barrier(0); }
        }
        __syncthreads();
        __syncthreads();
    }
}
#undef K2_GLOAD
#undef K2_LSTORE
#undef K2_ULOAD
#undef K2_BS
__device__ __forceinline__ void lru_unit(LAS unsigned char* lds, unsigned char* aux, int bb, int cg) {
    const int tid = threadIdx.x, ch = tid & 15, seg = tid >> 4;
    LAS float* P = (LAS float*)lds; LAS float* Hs = P + 512;
    const size_t off = ((size_t)bb * SEQ + (size_t)seg * 128) * 512 + cg * 16 + ch;
    const bf16_t* om = (const bf16_t*)(aux + AX_LOM) + off; bf16_t* lb = (bf16_t*)(aux + AX_LB) + off;
    float p = 1.f, hv = 0.f;
#pragma unroll 8
    for (int t = 0; t < 128; ++t) { const float a = 1.f - bf1(om[(size_t)t * 512]), b = bf1(lb[(size_t)t * 512]); hv = fmaf(a, hv, b); p *= a; }
    P[tid] = p; Hs[tid] = hv;
    __syncthreads();
    float carry = 0.f;
    for (int s = 0; s < seg; ++s) carry = fmaf(P[s * 16 + ch], carry, Hs[s * 16 + ch]);
    hv = carry;
#pragma unroll 8
    for (int t = 0; t < 128; ++t) { const float a = 1.f - bf1(om[(size_t)t * 512]), b = bf1(lb[(size_t)t * 512]); hv = fmaf(a, hv, b); lb[(size_t)t * 512] = to_bf1(hv); }
    __syncthreads();
}
__device__ __forceinline__ void b2_scan(const Args& A, LAS unsigned char* lds) {
    bf16_t* proj = (bf16_t*)(A.ws + WS_PROJ); unsigned char* aux = A.ws + WS_AUX;
    for (int u = blockIdx.x; u < 176; u += gridDim.x) {
        if (u < 16) k2_unit<true, 128>(lds, aux, proj, u);
        else if (u < 32) k2_unit<false, 128>(lds, aux, proj, u - 16);
        else if (u < 48) k2_unit<false, 64>(lds, aux, proj, u - 32);
        else { const int r = u - 48; lru_unit(lds, aux, r >> 5, r & 31); }
    }
}

__device__ __forceinline__ void b3_post(const Args& A, int l) {
    const int tid = threadIdx.x, lane = tid & 63, wave = __builtin_amdgcn_readfirstlane(tid >> 6), G = gridDim.x;
    bf16_t* proj = (bf16_t*)(A.ws + WS_PROJ); unsigned char* aux = A.ws + WS_AUX;
    const int cin = (lane & 15) * 8;
    float wn[3][8];
    { const float* p0 = A.in[I_GNORM] + l * 128 + cin; const float* p1 = A.in[I_HNORM] + l * 128 + cin; const float* p2 = A.in[I_DNORM] + l * 128 + cin;
#pragma unroll
        for (int j = 0; j < 8; ++j) { wn[0][j] = p0[j]; wn[1][j] = p1[j]; wn[2][j] = p2[j]; } }
    for (int row = blockIdx.x * NWAVES + wave; row < HM; row += G * NWAVES) {
        bf16_t* pr = proj + (size_t)row * NPROJ;
        float o[8], g[8], y[8];
        { const int bb = row >> 12, t = row & 4095, hh = lane >> 4; const size_t ci = (size_t)(bb * 4 + hh) * 64 + (t >> 6);
            load8((const bf16_t*)(aux + AX_GO) + (ci * 64 + (t & 63)) * 128 + cin, o); }
        load8(pr + C_AZ + lane * 8, g);
        { float ss = 0.f;
#pragma unroll
            for (int j = 0; j < 8; ++j) { o[j] *= 0.08838834764831845f; ss += o[j] * o[j]; }
            ss = row_sum16(ss); const float r = rsqrtf(ss * (1.f / 128.f) + EPS);
#pragma unroll
            for (int j = 0; j < 8; ++j) y[j] = o[j] * r * wn[0][j] * siluf_(g[j]);
            *(u32x4*)(pr + C_AZ + lane * 8) = pack8(y); }
        load8(pr + C_BI + lane * 8, o); load8(pr + C_BG + lane * 8, g);
        { float ss = 0.f;
#pragma unroll
            for (int j = 0; j < 8; ++j) { o[j] *= 0.08838834764831845f; ss += o[j] * o[j]; }
            ss = row_sum16(ss); const float r = rsqrtf(ss * (1.f / 128.f) + EPS);
#pragma unroll
            for (int j = 0; j < 8; ++j) y[j] = o[j] * r * wn[1][j] * siluf_(g[j]);
            *(u32x4*)(pr + C_BG + lane * 8) = pack8(y); }
        load8((const bf16_t*)(aux + AX_LB) + (size_t)row * 512 + lane * 8, o); load8(pr + C_CG + lane * 8, g);
#pragma unroll
        for (int j = 0; j < 8; ++j) y[j] = o[j] * gelu_tanh(g[j]);
        *(u32x4*)(pr + C_CG + lane * 8) = pack8(y);
        load8(pr + C_DV + lane * 8, o); load8(pr + C_DG + lane * 8, g);
        { float ss = 0.f;
#pragma unroll
            for (int j = 0; j < 8; ++j) { o[j] *= 0.125f; ss += o[j] * o[j]; }
            ss = row_sum16(ss); const float r = rsqrtf(ss * (1.f / 128.f) + EPS);
#pragma unroll
            for (int j = 0; j < 8; ++j) y[j] = o[j] * r * wn[2][j] * siluf_(g[j]);
            *(u32x4*)(pr + C_DG + lane * 8) = pack8(y); }
    }
}

__device__ const unsigned char PAIR_IJ[56] = {
    0x00, 0x01, 0x02, 0x03, 0x04, 0x05, 0x06, 0x07, 0x08, 0x09, 0x0A, 0x0B, 0x0C, 0x0D, 0x0E, 0x0F,
    0x10, 0x11, 0x12, 0x13, 0x14, 0x15, 0x16, 0x17, 0x20, 0x21, 0x22, 0x23, 0x24, 0x30, 0x31, 0x32, 0x33,
    0x40, 0x41, 0x42, 0x50, 0x51, 0x60, 0x61, 0x70, 0x71, 0x80, 0x90, 0xA0, 0xB0, 0xC0, 0xD0, 0xE0, 0xF0,
    0xFF, 0xFF, 0xFF, 0xFF, 0xFF, 0xFF };
__device__ __forceinline__ float fmax_dpp_quad(float m) { m = fmaxf(m, dpp_f<0xB1>(m)); m = fmaxf(m, dpp_f<0x4E>(m)); return m; }
typedef float f32x2 __attribute__((ext_vector_type(2)));
__device__ __forceinline__ float dot16_fp8(const u32x4 u, const float (&h)[16], float p) {
    const unsigned w0 = u.x, w1 = u.y, w2 = u.z, w3 = u.w;
    f32x2 a;
    a = __builtin_amdgcn_cvt_pk_f32_fp8((int)w0, false); p = fmaf(h[0], a.x, p); p = fmaf(h[1], a.y, p);
    a = __builtin_amdgcn_cvt_pk_f32_fp8((int)w0, true);  p = fmaf(h[2], a.x, p); p = fmaf(h[3], a.y, p);
    a = __builtin_amdgcn_cvt_pk_f32_fp8((int)w1, false); p = fmaf(h[4], a.x, p); p = fmaf(h[5], a.y, p);
    a = __builtin_amdgcn_cvt_pk_f32_fp8((int)w1, true);  p = fmaf(h[6], a.x, p); p = fmaf(h[7], a.y, p);
    a = __builtin_amdgcn_cvt_pk_f32_fp8((int)w2, false); p = fmaf(h[8], a.x, p); p = fmaf(h[9], a.y, p);
    a = __builtin_amdgcn_cvt_pk_f32_fp8((int)w2, true);  p = fmaf(h[10], a.x, p); p = fmaf(h[11], a.y, p);
    a = __builtin_amdgcn_cvt_pk_f32_fp8((int)w3, false); p = fmaf(h[12], a.x, p); p = fmaf(h[13], a.y, p);
    a = __builtin_amdgcn_cvt_pk_f32_fp8((int)w3, true);  p = fmaf(h[14], a.x, p); p = fmaf(h[15], a.y, p);
    return p;
}
__device__ __forceinline__ void axpy16_fp8(const u32x4 v, float c, float (&acc)[16]) {
    const unsigned w0 = v.x, w1 = v.y, w2 = v.z, w3 = v.w;
    f32x2 a;
    a = __builtin_amdgcn_cvt_pk_f32_fp8((int)w0, false); acc[0] = fmaf(c, a.x, acc[0]); acc[1] = fmaf(c, a.y, acc[1]);
    a = __builtin_amdgcn_cvt_pk_f32_fp8((int)w0, true);  acc[2] = fmaf(c, a.x, acc[2]); acc[3] = fmaf(c, a.y, acc[3]);
    a = __builtin_amdgcn_cvt_pk_f32_fp8((int)w1, false); acc[4] = fmaf(c, a.x, acc[4]); acc[5] = fmaf(c, a.y, acc[5]);
    a = __builtin_amdgcn_cvt_pk_f32_fp8((int)w1, true);  acc[6] = fmaf(c, a.x, acc[6]); acc[7] = fmaf(c, a.y, acc[7]);
    a = __builtin_amdgcn_cvt_pk_f32_fp8((int)w2, false); acc[8] = fmaf(c, a.x, acc[8]); acc[9] = fmaf(c, a.y, acc[9]);
    a = __builtin_amdgcn_cvt_pk_f32_fp8((int)w2, true);  acc[10] = fmaf(c, a.x, acc[10]); acc[11] = fmaf(c, a.y, acc[11]);
    a = __builtin_amdgcn_cvt_pk_f32_fp8((int)w3, false); acc[12] = fmaf(c, a.x, acc[12]); acc[13] = fmaf(c, a.y, acc[13]);
    a = __builtin_amdgcn_cvt_pk_f32_fp8((int)w3, true);  acc[14] = fmaf(c, a.x, acc[14]); acc[15] = fmaf(c, a.y, acc[15]);
}
constexpr int PE_LDS_WAVE = 4096;
__device__ __forceinline__ void pe_peer(const Args& A, LAS unsigned char* lds, int l, bool last) {
    const int tid = threadIdx.x, lane = tid & 63, wave = __builtin_amdgcn_readfirstlane(tid >> 6), G = gridDim.x;
    const float NEG_INF = __uint_as_float(0xFF800000u);
    LAS unsigned* tl = (LAS unsigned*)(lds + wave * PE_LDS_WAVE);
    LAS unsigned* el = tl + 256;
    LAS float* gl = (LAS float*)(el + 128);
    LAS float* sul = gl + 128;
    LAS float* svl = sul + 128;
    float* X = A.out; bf16_t* XB = (bf16_t*)(A.ws + WS_XB); float* rstd1 = (float*)(A.ws + WS_RSTD1);
    const float* SC = (const float*)(A.ws + WS_SCORES);
    const unsigned char* U = A.ws + WS_U8; const unsigned char* V = A.ws + WS_V8;
    const float* SU = (const float*)(A.ws + WS_SU); const float* SV = (const float*)(A.ws + WS_SV);
    const float* nf = A.in[I_NFFN] + l * DM; const float* nfin = A.in[I_NFIN];
    for (int n = blockIdx.x * NWAVES + wave; n < MTOK; n += G * NWAVES) {
        float h[16]; float rstd2;
        { const float* xr = X + (size_t)n * DM + 16 * lane; const float* wr = nf + 16 * lane;
            float ss = 0.f;
#pragma unroll
            for (int j = 0; j < 4; ++j) { const f32x4 a = *(const f32x4*)(xr + 4 * j); h[4 * j] = a[0]; h[4 * j + 1] = a[1]; h[4 * j + 2] = a[2]; h[4 * j + 3] = a[3];
                ss += (a[0] * a[0] + a[1] * a[1]) + (a[2] * a[2] + a[3] * a[3]); }
            ss = wave_sum64(ss); rstd2 = rsqrtf(ss * (1.f / DM) + EPS);
#pragma unroll
            for (int j = 0; j < 4; ++j) { const f32x4 w = *(const f32x4*)(wr + 4 * j); h[4 * j] *= rstd2 * w[0]; h[4 * j + 1] *= rstd2 * w[1]; h[4 * j + 2] *= rstd2 * w[2]; h[4 * j + 3] *= rstd2 * w[3]; } }
        {
            const int sub = lane & 3, gidx = lane >> 2;
            const float* sp = SC + (size_t)n * 2048 + gidx * 128 + sub * 32;
            float val[32];
#pragma unroll
            for (int q = 0; q < 8; ++q) { const f32x4 s = *(const f32x4*)(sp + q * 4);
#pragma unroll
                for (int j = 0; j < 4; ++j) val[q * 4 + j] = __uint_as_float((__float_as_uint(s[j]) & ~0x7Fu) | (unsigned)(sub * 32 + q * 4 + j)); }
            float top[16];
#pragma unroll
            for (int it = 0; it < 16; ++it) {
                float m = val[0];
#pragma unroll
                for (int i = 1; i < 32; ++i) m = fmaxf(m, val[i]);
                m = fmax_dpp_quad(m);
                top[it] = m;
#pragma unroll
                for (int i = 0; i < 32; ++i) val[i] = (__float_as_uint(val[i]) == __float_as_uint(m)) ? NEG_INF : val[i];
            }
            if (sub == 0) {
#pragma unroll
                for (int it = 0; it < 16; ++it) tl[gidx * 16 + it] = __float_as_uint(top[it]); }
        }
        __builtin_amdgcn_wave_barrier(); asm volatile("s_waitcnt lgkmcnt(0)" ::: "memory");
        {
            const int hh = lane >> 3, slot = lane & 7;
            float cand[7];
#pragma unroll
            for (int q = 0; q < 7; ++q) { const unsigned code = PAIR_IJ[slot + 8 * q];
                if (code != 0xFFu) { const float a = __uint_as_float(tl[(2 * hh) * 16 + (code >> 4)] & ~0x7Fu), b = __uint_as_float(tl[(2 * hh + 1) * 16 + (code & 15u)] & ~0x7Fu);
                    cand[q] = __uint_as_float((__float_as_uint(a + b) & ~0xFFu) | code); }
                else cand[q] = NEG_INF; }
            float best[16];
#pragma unroll
            for (int it = 0; it < 16; ++it) {
                float m = cand[0];
#pragma unroll
                for (int q = 1; q < 7; ++q) m = fmaxf(m, cand[q]);
                m = fmax_dpp_quad(m); m = fmaxf(m, dpp_f<0x141>(m));
                best[it] = m;
#pragma unroll
                for (int q = 0; q < 7; ++q) cand[q] = (__float_as_uint(cand[q]) == __float_as_uint(m)) ? NEG_INF : cand[q];
            }
            const float b0 = __uint_as_float(__float_as_uint(best[0]) & ~0xFFu);
            float e[16], es = 0.f;
#pragma unroll
            for (int k = 0; k < 16; ++k) { e[k] = __expf((__uint_as_float(__float_as_uint(best[k]) & ~0xFFu) - b0) * rstd2); es += e[k]; }
            const float inv = 1.f / es;
#pragma unroll
            for (int k = 0; k < 16; ++k) if ((k & 7) == slot) { const unsigned code = __float_as_uint(best[k]) & 0xFFu;
                const unsigned i0 = tl[(2 * hh) * 16 + (code >> 4)] & 0x7Fu, i1 = tl[(2 * hh + 1) * 16 + (code & 15u)] & 0x7Fu, ex = i0 * 128u + i1;
                el[hh * 16 + k] = ex; gl[hh * 16 + k] = e[k] * inv; sul[hh * 16 + k] = SU[ex]; svl[hh * 16 + k] = SV[ex]; }
        }
        __builtin_amdgcn_wave_barrier(); asm volatile("s_waitcnt lgkmcnt(0)" ::: "memory");
        float acc[16];
#pragma unroll
        for (int i = 0; i < 16; ++i) acc[i] = 0.f;
#define PE_LOAD(ub_, vb_, b_) do { _Pragma("unroll") for (int r = 0; r < 4; ++r) { const unsigned e_ = (unsigned)__builtin_amdgcn_readfirstlane((int)el[(b_) * 4 + r]); \
            ub_[r] = *(const u32x4*)(U + (size_t)e_ * DM + 16 * lane); vb_[r] = *(const u32x4*)(V + (size_t)e_ * DM + 16 * lane); } } while (0)
#define PE_COMP(ub_, vb_, b_) do { _Pragma("unroll") for (int r = 0; r < 4; ++r) { \
            float p = dot16_fp8(ub_[r], h, 0.f); p = wave_sum64(p); \
            const float c = gl[(b_) * 4 + r] * gelu_tanh(p * sul[(b_) * 4 + r]) * svl[(b_) * 4 + r]; \
            axpy16_fp8(vb_[r], c, acc); } } while (0)
        {
            u32x4 uA[4], vA[4], uB[4], vB[4];
            PE_LOAD(uA, vA, 0);
#pragma unroll 1
            for (int b = 0; b < 32; b += 2) {
                PE_LOAD(uB, vB, b + 1);
                PE_COMP(uA, vA, b);
                if (b + 2 < 32) PE_LOAD(uA, vA, b + 2);
                PE_COMP(uB, vB, b + 1);
            }
        }
#undef PE_LOAD
#undef PE_COMP
        { float* xr = X + (size_t)n * DM + 16 * lane;
            f32x4 a[4]; float ss = 0.f;
#pragma unroll
            for (int j = 0; j < 4; ++j) { a[j] = *(const f32x4*)(xr + 4 * j); a[j][0] += acc[4 * j]; a[j][1] += acc[4 * j + 1]; a[j][2] += acc[4 * j + 2]; a[j][3] += acc[4 * j + 3];
                ss += (a[j][0] * a[j][0] + a[j][1] * a[j][1]) + (a[j][2] * a[j][2] + a[j][3] * a[j][3]); }
            ss = wave_sum64(ss); const float rs = rsqrtf(ss * (1.f / DM) + EPS);
            if (!last) {
#pragma unroll
                for (int j = 0; j < 4; ++j) *(f32x4*)(xr + 4 * j) = a[j];
                bf16_t* bp = XB + (size_t)n * DM + 16 * lane;
                u32x4 o; o.x = pk_bf16(a[0][0], a[0][1]); o.y = pk_bf16(a[0][2], a[0][3]); o.z = pk_bf16(a[1][0], a[1][1]); o.w = pk_bf16(a[1][2], a[1][3]); *(u32x4*)bp = o;
                o.x = pk_bf16(a[2][0], a[2][1]); o.y = pk_bf16(a[2][2], a[2][3]); o.z = pk_bf16(a[3][0], a[3][1]); o.w = pk_bf16(a[3][2], a[3][3]); *(u32x4*)(bp + 8) = o;
                if (lane == 0) rstd1[n] = rs;
            } else {
#pragma unroll
                for (int j = 0; j < 4; ++j) { const f32x4 w = *(const f32x4*)(nfin + 16 * lane + 4 * j); *(f32x4*)(xr + 4 * j) = a[j] * rs * w; }
            }
        }
        __builtin_amdgcn_wave_barrier(); asm volatile("s_waitcnt lgkmcnt(0)" ::: "memory");
    }
}

__global__ void __launch_bounds__(NTHREADS, 2) fwd_kernel(Args A) {
    extern __shared__ __attribute__((aligned(16))) unsigned char smem[];
    LAS unsigned char* lds = (LAS unsigned char*)smem;
    const int tid = threadIdx.x, G = gridDim.x;
    const int lo = A.lo, hi = A.hi;
#define IN(k) (lo <= (k) && (k) < hi)
#define BOTH(k) (IN(k) && IN((k) + 1))
    volatile LAS unsigned* misc = (volatile LAS unsigned*)(lds + LDS_MISC);
    if (tid < 16) misc[tid] = 0u;
    __syncthreads();
    XcdBarrier bar; bar.bar = (unsigned*)(A.ws + WS_BAR); bar.x = 0; bar.st = misc;
    if (hi - lo > 1) bar = xcd_barrier_post((unsigned*)(A.ws + WS_BAR), misc);
#define SEAM(k) do { if (BOTH(k)) xcd_barrier(bar); } while (0)

#ifndef PHM
#define PHM 0xFF
#endif
    if (IN(0)) { if (PHM & 1) p0_prologue(A, lds); SEAM(0); }
#define RUN_HALF(l, half) do { \
        const int ph = 1 + (l) * 12 + (half) * 5; \
        if (IN(ph + 0)) { \
            pg8::Gemm g{(const bf16_t*)(A.ws + WS_XB) + (size_t)(half) * HM * DM, (const bf16_t*)(A.ws + WS_WIN) + (size_t)(l) * NPROJP * DM, HM, NPROJP, DM, DM}; \
            pg8::StaticOrder S; S.init(HM, NPROJP, G, (int)blockIdx.x); \
            pg8::EpiProj E{(bf16_t*)(A.ws + WS_PROJ), (const float*)(A.ws + WS_RSTD1) + (half) * HM}; \
            if (PHM & 2) pg8::gemm_phase<pg8::EpiProj>(lds, g, S, E); \
            SEAM(ph + 0); \
        } \
        if (IN(ph + 1)) { if (PHM & 4) b1_prep(A, lds, (l), (half)); SEAM(ph + 1); } \
        if (IN(ph + 2)) { if (PHM & 8) b2_scan(A, lds); SEAM(ph + 2); } \
        if (IN(ph + 3)) { if (PHM & 16) b3_post(A, (l)); SEAM(ph + 3); } \
        if (IN(ph + 4)) { \
            pg8::Gemm g{(const bf16_t*)(A.ws + WS_PROJ) + C_Y, (const bf16_t*)(A.ws + WS_WOUT) + (size_t)(l) * DM * 2048, HM, DM, 2048, NPROJ}; \
            pg8::StaticOrder S; S.init(HM, DM, G, (int)blockIdx.x); \
            pg8::EpiResid E{A.out + (size_t)(half) * HM * DM, (bf16_t*)(A.ws + WS_XB) + (size_t)(half) * HM * DM}; \
            if (PHM & 32) pg8::gemm_phase<pg8::EpiResid>(lds, g, S, E); \
            SEAM(ph + 4); \
        } } while (0)
#define RUN_TAIL(l) do { \
        const int pb = 1 + (l) * 12; \
        if (IN(pb + 10)) { \
            pg8::Gemm g{(const bf16_t*)(A.ws + WS_XB), (const bf16_t*)(A.ws + WS_WEFF) + (size_t)(l) * 2048 * DM, MTOK, 2048, DM, DM}; \
            pg8::StaticOrder S; S.init(MTOK, 2048, G, (int)blockIdx.x); \
            pg8::EpiF32 E{(float*)(A.ws + WS_SCORES), 2048}; \
            convert_tables(A, (l)); \
            if (PHM & 64) pg8::gemm_phase<pg8::EpiF32>(lds, g, S, E); \
            SEAM(pb + 10); \
        } \
        if (IN(pb + 11)) { if (PHM & 128) pe_peer(A, lds, (l), (l) == NLAYER - 1); SEAM(pb + 11); } } while (0)
    RUN_HALF(0, 0); RUN_HALF(0, 1); RUN_TAIL(0);
    RUN_HALF(1, 0); RUN_HALF(1, 1); RUN_TAIL(1);
#undef RUN_HALF
#undef RUN_TAIL
#undef IN
#undef BOTH
#undef SEAM
}
constexpr int NPHASES = 1 + NLAYER * 12;

extern "C" void kernel_launch(void* const* d_in, const int* in_sizes, int n_in, void* d_out, int out_size, void* d_ws, size_t ws_size, hipStream_t stream) {
    static int grid = 0;
    if (grid == 0) {
        if (n_in != 26 || out_size != MTOK * DM || ws_size < WS_END) { fprintf(stderr, "kernel_launch: unexpected shapes (n_in %d out %d ws %zu need %zu)\n", n_in, out_size, ws_size, (size_t)WS_END); grid = -1; return; }
        int dev = 0, cus = 0;
        if (hipGetDevice(&dev) != hipSuccess || hipDeviceGetAttribute(&cus, hipDeviceAttributeMultiprocessorCount, dev) != hipSuccess) { grid = -1; return; }
        if (hipFuncSetAttribute((const void*)fwd_kernel, hipFuncAttributeMaxDynamicSharedMemorySize, LDS_BYTES) != hipSuccess) { fprintf(stderr, "kernel_launch: hipFuncSetAttribute failed\n"); grid = -1; return; }
        int per_cu = 0;
        if (hipOccupancyMaxActiveBlocksPerMultiprocessor(&per_cu, (const void*)fwd_kernel, NTHREADS, LDS_BYTES) != hipSuccess || per_cu < 1) { fprintf(stderr, "kernel_launch: occupancy query says %d\n", per_cu); (void)hipGetLastError(); }
        grid = cus;
    }
    if (grid < 0) return;
    (void)hipMemsetAsync((char*)d_ws + WS_BAR, 0, 16384, stream);
    Args a{};
    for (int i = 0; i < 26; ++i) a.in[i] = (const float*)d_in[i];
    a.out = (float*)d_out; a.ws = (unsigned char*)d_ws;
#if MK_N_LAUNCHES == 1
    a.lo = 0; a.hi = NPHASES;
    hipLaunchKernelGGL(fwd_kernel, dim3(grid), dim3(NTHREADS), LDS_BYTES, stream, a);
#else
    for (int p = 0; p < NPHASES; ++p) { a.lo = p; a.hi = p + 1; hipLaunchKernelGGL(fwd_kernel, dim3(grid), dim3(NTHREADS), LDS_BYTES, stream, a); }
#endif
}
```

```cpp
#include <hip/hip_runtime.h>
#include <stdint.h>
#include <cstdio>

#ifndef MK_N_LAUNCHES
#define MK_N_LAUNCHES 1
#endif

#define LAS __attribute__((address_space(3)))
typedef unsigned short bf16_t;
typedef short bf16x8 __attribute__((ext_vector_type(8)));
typedef float f32x4 __attribute__((ext_vector_type(4)));
typedef unsigned u32x4 __attribute__((ext_vector_type(4)));
typedef unsigned u32x2 __attribute__((ext_vector_type(2)));
typedef __bf16 bf16v2 __attribute__((ext_vector_type(2)));

constexpr int DM = 1024, SEQ = 4096, NBATCH = 8, MTOK = NBATCH * SEQ, HM = MTOK / 2, NLAYER = 2;
constexpr int NPROJ = 6680, NPROJP = 6912;
constexpr float EPS = 1e-6f;
constexpr int C_AQ = 0, C_AK = 512, C_AV = 1024, C_BQ = 1536, C_BF = 2048, C_BI = 2560, C_CX = 3072, C_DQ = 3584, C_DK = 3840, C_DV = 4096,
              C_AZ = 4608, C_BG = 5120, C_CG = 5632, C_DG = 6144, C_AA = 6656, C_AB = 6660, C_DLR = 6664, C_Y = 4608;
constexpr int NCI = 1024;
constexpr size_t AX_GW = 0,
                 AX_GQ = AX_GW + (size_t)NCI * 64 * 128 * 2,
                 AX_GUT = AX_GQ + (size_t)NCI * 64 * 128 * 2,
                 AX_GKT = AX_GUT + (size_t)NCI * 64 * 128 * 2,
                 AX_GO = AX_GKT + (size_t)NCI * 64 * 128 * 2,
                 AX_GQK = AX_GO + (size_t)NCI * 64 * 128 * 2,
                 AX_GGL = AX_GQK + (size_t)NCI * 64 * 64 * 2,
                 AX_HATT = AX_GGL + (size_t)NCI * 4,
                 AX_HKT = AX_HATT + (size_t)NCI * 64 * 64 * 2,
                 AX_HGD = AX_HKT + (size_t)NCI * 128 * 64 * 2,
                 AX_DATT = AX_HGD + (size_t)NCI * 128 * 4,
                 AX_DKT = AX_DATT + (size_t)NCI * 64 * 64 * 2,
                 AX_DGD = AX_DKT + (size_t)NCI * 64 * 64 * 2,
                 AX_LOM = AX_DGD + (size_t)NCI * 64 * 4,
                 AX_LB = AX_LOM + (size_t)HM * 512 * 2,
                 AX_END = AX_LB + (size_t)HM * 512 * 2;
constexpr size_t WS_BAR = 0, WS_RSTD1 = 16384, WS_WIN = WS_RSTD1 + (size_t)MTOK * 4, WS_WOUT = WS_WIN + (size_t)NLAYER * NPROJP * DM * 2,
                 WS_WEFF = WS_WOUT + (size_t)NLAYER * DM * 2048 * 2, WS_LRUW = WS_WEFF + (size_t)NLAYER * 2048 * DM * 2,
                 WS_SU = WS_LRUW + (size_t)NLAYER * 2 * 4 * 128 * 128 * 2, WS_SV = WS_SU + (size_t)16384 * 4, WS_XB = WS_SV + (size_t)16384 * 4,
                 WS_PROJ = WS_XB + (size_t)MTOK * DM * 2, WS_AUX = WS_PROJ + (size_t)HM * NPROJ * 2, WS_END = WS_AUX + AX_END,
                 WS_SCORES = WS_PROJ,
                 WS_U8 = WS_SCORES + (size_t)MTOK * 2048 * 4,
                 WS_V8 = WS_U8 + (size_t)16384 * DM / 2;
static_assert(WS_V8 + (size_t)16384 * DM / 2 <= WS_END, "scores + expert tables alias");
static_assert(WS_PROJ % 256 == 0 && WS_AUX % 16 == 0 && WS_WIN % 256 == 0 && AX_GGL % 16 == 0 && AX_HATT % 16 == 0 && AX_LOM % 16 == 0, "alignment");

#define XB_TMO      128
#define XB_XCNT(j)  (256  + 64 * (j))
#define XB_XSUB(j)  (1280 + 64 * (j))
#define XB_XGEN(j)  (2304 + 64 * (j))
#define XB_TOP      3328
#define XB_TOPGEN   3392
#define XCD_BAR_WORDS 3456
#define XB_SPIN_CAP (1u << 24)
__device__ __forceinline__ unsigned xb_ld(unsigned* p)              { return __hip_atomic_load(p, __ATOMIC_RELAXED, __HIP_MEMORY_SCOPE_AGENT); }
__device__ __forceinline__ unsigned xb_add(unsigned* p, unsigned v) { return __hip_atomic_fetch_add(p, v, __ATOMIC_RELAXED, __HIP_MEMORY_SCOPE_AGENT); }
__device__ __forceinline__ unsigned xb_xcc_id() { return (unsigned)__builtin_amdgcn_s_getreg((3 << 11) | 20) & 0xFu; }
#define XB_SPIN(cond, bar) do { unsigned _sp = 0; while (cond) { __builtin_amdgcn_s_sleep(1); \
    if ((++_sp & 255u) == 0u) { if (xb_ld(&(bar)[XB_TMO])) break; if (_sp > XB_SPIN_CAP) { atomicAdd(&(bar)[XB_TMO], 1u); break; } } } } while (0)
struct XcdBarrier { unsigned* bar; unsigned x; volatile LAS unsigned* st; };
__device__ __forceinline__ XcdBarrier xcd_barrier_post(unsigned* bar, volatile LAS unsigned* st) {
    XcdBarrier b; b.bar = bar; b.x = xb_xcc_id(); b.st = st;
    if (threadIdx.x == 0) (void)xb_add(&bar[XB_XCNT(b.x)], 1u);
    return b;
}
__device__ __forceinline__ void xcd_barrier_complete(unsigned* bar, unsigned x, unsigned& nloc, unsigned& nx) {
    const unsigned G = gridDim.x * gridDim.y * gridDim.z;
    unsigned sum, cnt, mine, sp = 0u;
    for (;;) {
        sum = 0u; cnt = 0u; mine = 0u;
#pragma unroll
        for (unsigned j = 0; j < 16; ++j) { const unsigned c = xb_ld(&bar[XB_XCNT(j)]); sum += c; cnt += (c > 0u) ? 1u : 0u; mine = (j == x) ? c : mine; }
        if (sum == G) break;
        __builtin_amdgcn_s_sleep(1);
        if ((++sp & 255u) == 0u) { if (xb_ld(&bar[XB_TMO])) break; if (sp > XB_SPIN_CAP) { atomicAdd(&bar[XB_TMO], 1u); break; } }
    }
    nloc = mine > 0u ? mine : 1u; nx = cnt > 0u ? cnt : 1u;
}
__device__ __forceinline__ void xcd_barrier(const XcdBarrier& b) {
    asm volatile("s_waitcnt vmcnt(0)" ::: "memory");
    __syncthreads();
    if (threadIdx.x == 0) {
        unsigned* bar = b.bar;
        __builtin_amdgcn_s_waitcnt(0);
        unsigned nloc = b.st[0], nx = b.st[1];
        if (nloc == 0u) { xcd_barrier_complete(bar, b.x, nloc, nx); b.st[0] = nloc; b.st[1] = nx; }
        const unsigned old = xb_add(&bar[XB_XSUB(b.x)], 1u);
        const unsigned gen = old / nloc;
        if (old + 1u == (gen + 1u) * nloc) {
            __builtin_amdgcn_fence(__ATOMIC_RELEASE, "agent");
            asm volatile("s_waitcnt vmcnt(0)" ::: "memory");
            const unsigned og = xb_add(&bar[XB_TOP], 1u);
            const unsigned tg = og / nx;
            if (og + 1u == (tg + 1u) * nx) xb_add(&bar[XB_TOPGEN], 1u);
            else XB_SPIN(xb_ld(&bar[XB_TOPGEN]) == tg, bar);
            __builtin_amdgcn_fence(__ATOMIC_ACQUIRE, "agent");
            xb_add(&bar[XB_XGEN(b.x)], 1u);
            asm volatile("s_waitcnt vmcnt(0)" ::: "memory");
        } else {
            XB_SPIN(xb_ld(&bar[XB_XGEN(b.x)]) == gen, bar);
            __builtin_amdgcn_fence(__ATOMIC_ACQUIRE, "agent");
            asm volatile("s_waitcnt vmcnt(0)" ::: "memory");
        }
    }
    __syncthreads();
}

__device__ __forceinline__ float bf_lo(unsigned u) { return __uint_as_float(u << 16); }
__device__ __forceinline__ float bf_hi(unsigned u) { return __uint_as_float(u & 0xffff0000u); }
__device__ __forceinline__ float bf1(bf16_t h) { return __uint_as_float(((unsigned)h) << 16); }
__device__ __forceinline__ unsigned pk_bf16(float lo, float hi) { bf16v2 v; v.x = (__bf16)lo; v.y = (__bf16)hi; return __builtin_bit_cast(unsigned, v); }
__device__ __forceinline__ bf16_t to_bf1(float f) { return (bf16_t)(pk_bf16(f, 0.f) & 0xffffu); }
__device__ __forceinline__ void unpack8(const u32x4 v, float (&f)[8]) {
    f[0] = bf_lo(v.x); f[1] = bf_hi(v.x); f[2] = bf_lo(v.y); f[3] = bf_hi(v.y); f[4] = bf_lo(v.z); f[5] = bf_hi(v.z); f[6] = bf_lo(v.w); f[7] = bf_hi(v.w);
}
__device__ __forceinline__ u32x4 pack8(const float (&f)[8]) { u32x4 o; o.x = pk_bf16(f[0], f[1]); o.y = pk_bf16(f[2], f[3]); o.z = pk_bf16(f[4], f[5]); o.w = pk_bf16(f[6], f[7]); return o; }
__device__ __forceinline__ float fast_rcp(float x) { return __builtin_amdgcn_rcpf(x); }
__device__ __forceinline__ float sigmoidf_(float x) { return fast_rcp(1.f + __expf(-x)); }
__device__ __forceinline__ float siluf_(float x) { return x * sigmoidf_(x); }
__device__ __forceinline__ float softplusf_(float x) { return fmaxf(x, 0.f) + log1pf(__expf(-fabsf(x))); }
__device__ __forceinline__ float gelu_tanh(float x) {
    const float u = 0.7978845608028654f * (x + 0.044715f * x * x * x);
    const float t = 1.f - 2.f * fast_rcp(__expf(2.f * u) + 1.f);
    return 0.5f * x * (1.f + t);
}
template <int CTRL> __device__ __forceinline__ float dpp_f(float v) { return __int_as_float(__builtin_amdgcn_update_dpp(0, __float_as_int(v), CTRL, 0xf, 0xf, true)); }
__device__ __forceinline__ float row_sum16(float v) { v += dpp_f<0x128>(v); v += dpp_f<0x124>(v); v += dpp_f<0x122>(v); v += dpp_f<0x121>(v); return v; }
__device__ __forceinline__ float rdlane(float v, int l) { return __int_as_float(__builtin_amdgcn_readlane(__float_as_int(v), l)); }
__device__ __forceinline__ float wave_sum64(float v) { v = row_sum16(v); return (rdlane(v, 0) + rdlane(v, 16)) + (rdlane(v, 32) + rdlane(v, 48)); }

namespace pg8 {
constexpr int BM = 256, BK = 64, HALF = 128, HTB = HALF * BK * 2, STAGE_BYTES = 8 * HTB, NXCD = 8, WGM = 8;
__host__ __device__ __forceinline__ int lds_byte(int r, int c) { const int st = (r >> 4) * 2 + (c >> 5), rr = r & 15, cc = c & 31, ob = rr * 64 + cc * 2; return st * 1024 + (ob ^ (((ob >> 9) & 1) << 5)); }
__host__ __device__ __forceinline__ void stage_rc(int b, int& R, int& C) { const int st = b / 1024, sb = b % 1024, swz = sb ^ (((sb >> 9) & 1) << 5); R = (st >> 1) * 16 + swz / 64; C = (st & 1) * 32 + (swz % 64) / 2; }
__host__ __device__ __forceinline__ int perm32(int rho) { const int n = rho >> 4, i = rho & 15; return 8 * (i >> 2) + 4 * n + (i & 3); }
struct Unit { int pm, pn; };
struct Gemm { const bf16_t* A; const bf16_t* Bt; int M, N, K, lda; };
struct StaticOrder {
    int nM, nN, nwg, G, c;
    __device__ void init(int M, int N, int G_, int c_) { nM = M / BM; nN = N / BM; nwg = nM * nN; G = G_; c = c_; }
    __device__ bool next(int i, Unit& u) const {
        const long L = (long)i * G + c; if (L >= nwg) return false;
        int wgid = (int)L; { const int q = nwg / NXCD, r = nwg % NXCD, xcd = wgid % NXCD, off = wgid / NXCD; wgid = (xcd < r ? xcd * (q + 1) : r * (q + 1) + (xcd - r) * q) + off; }
        const int nig = WGM * nN, gid = wgid / nig, fm = gid * WGM, gsz = (nM - fm) < WGM ? (nM - fm) : WGM;
        u.pm = fm + ((wgid % nig) % gsz); u.pn = (wgid % nig) / gsz; return true;
    }
};
template <class Epi>
__device__ __forceinline__ void gemm_phase(LAS unsigned char* lds, const Gemm g, const StaticOrder& S, const Epi& E) {
    const int tid = threadIdx.x, wid = __builtin_amdgcn_readfirstlane(tid >> 6), lane = tid & 63, wr = wid >> 2, wc = wid & 3, fr = lane & 15, fq = lane >> 4;
    const int K = g.K, nt = K / BK;
    unsigned voffA[2], voffB[2];
#pragma unroll
    for (int i = 0; i < 2; ++i) { int R, C; stage_rc(tid * 16 + i * 8192, R, C); const int Rb = (R & ~31) + perm32(R & 31);
        voffA[i] = (unsigned)(R * g.lda + C) * 2u; voffB[i] = (unsigned)(Rb * K + C) * 2u; }
    const size_t kstep = (size_t)(BK * 2);
    const size_t hsA = (size_t)HALF * g.lda * 2, hsB = (size_t)HALF * K * 2;
    const size_t tsA = 2 * hsA, tsB = 2 * hsB;
    const unsigned ldsw = (unsigned)wid * 1024u;
    const int aoff = lds_byte(wr * 64 + fr, fq * 8), boff = lds_byte(wc * 32 + fr, fq * 8);
#define PG8_SA(b, h) (((b) * 2 + (h)) * HTB)
#define PG8_SB(b, h) ((4 + (b) * 2 + (h)) * HTB)
#define PG8_STAGE(bufoff, gbase, voff) do { _Pragma("unroll") for (int _i = 0; _i < 2; ++_i) \
        __builtin_amdgcn_global_load_lds((const unsigned*)((const char*)(gbase) + (voff)[_i]), (LAS unsigned*)(lds + (bufoff) + ldsw + _i * 8192), 16, 0, 0); } while (0)
#define PG8_LDA(dst, b, h) do { _Pragma("unroll") for (int m = 0; m < 4; ++m) _Pragma("unroll") for (int k = 0; k < 2; ++k) dst[m][k] = *(const LAS bf16x8*)(lds + PG8_SA(b, h) + aoff + m * 2048 + k * 1024); } while (0)
#define PG8_LDB(dst, b, h) do { _Pragma("unroll") for (int n = 0; n < 2; ++n) _Pragma("unroll") for (int k = 0; k < 2; ++k) dst[n][k] = *(const LAS bf16x8*)(lds + PG8_SB(b, h) + boff + n * 2048 + k * 1024); } while (0)
#define PG8_MMA(ai, bj, At, Bt) do { __builtin_amdgcn_s_setprio(1); _Pragma("unroll") for (int m = 0; m < 4; ++m) _Pragma("unroll") for (int n = 0; n < 2; ++n) _Pragma("unroll") for (int k = 0; k < 2; ++k) \
        acc[ai][bj][m][n] = __builtin_amdgcn_mfma_f32_16x16x32_bf16(Bt[n][k], At[m][k], acc[ai][bj][m][n], 0, 0, 0); __builtin_amdgcn_s_setprio(0); } while (0)
#define PG8_WAIT_V(n) asm volatile("s_waitcnt vmcnt(" #n ")" ::: "memory")
#define PG8_WAIT_L(n) asm volatile("s_waitcnt lgkmcnt(" #n ")" ::: "memory")
#define PG8_BAR __builtin_amdgcn_s_barrier()
#define PG8_SCHED __builtin_amdgcn_sched_barrier(0)
    Unit cur, nxt; int ui = 0;
    if (!S.next(0, cur)) return;
    f32x4 acc[2][2][4][2];
#pragma unroll
    for (int a = 0; a < 2; ++a)
#pragma unroll
        for (int b = 0; b < 2; ++b)
#pragma unroll
            for (int m = 0; m < 4; ++m)
#pragma unroll
                for (int n = 0; n < 2; ++n) acc[a][b][m][n] = (f32x4){0.f, 0.f, 0.f, 0.f};
    bf16x8 At[4][2], B0[2][2], B1[2][2];
    const char* cA = (const char*)g.A + (size_t)cur.pm * tsA; const char* cB = (const char*)g.Bt + (size_t)cur.pn * tsB;
    PG8_STAGE(PG8_SB(0, 0), cB, voffB); PG8_STAGE(PG8_SA(0, 0), cA, voffA); PG8_STAGE(PG8_SB(0, 1), cB + hsB, voffB); PG8_STAGE(PG8_SA(0, 1), cA + hsA, voffA);
    if (wr == 1) PG8_BAR;
    PG8_WAIT_V(4); PG8_BAR;
    PG8_STAGE(PG8_SB(1, 0), cB + kstep, voffB); PG8_STAGE(PG8_SA(1, 0), cA + kstep, voffA); PG8_STAGE(PG8_SB(1, 1), cB + hsB + kstep, voffB);
    PG8_WAIT_V(6); PG8_BAR;
    for (;;) {
        const bool has_next = S.next(ui + 1, nxt);
        const char* nA = has_next ? (const char*)g.A + (size_t)nxt.pm * tsA : cA; const char* nB = has_next ? (const char*)g.Bt + (size_t)nxt.pn * tsB : cB;
        for (int t = 0; t < nt; t += 2) {
            const bool last = (t == nt - 2);
            const char* a1 = cA + (size_t)(t + 1) * kstep;
            const char* a2 = last ? nA : cA + (size_t)(t + 2) * kstep; const char* b2 = last ? nB : cB + (size_t)(t + 2) * kstep;
            const char* a3 = a2 + kstep; const char* b3 = b2 + kstep;
            PG8_LDB(B0, 0, 0); PG8_SCHED; PG8_LDA(At, 0, 0); PG8_STAGE(PG8_SA(1, 1), a1 + hsA, voffA);
            PG8_WAIT_L(8); PG8_BAR; PG8_WAIT_L(0); PG8_MMA(0, 0, At, B0); PG8_BAR; PG8_SCHED;
            PG8_LDB(B1, 0, 1); PG8_STAGE(PG8_SB(0, 0), b2, voffB);
            PG8_BAR; PG8_WAIT_L(0); PG8_MMA(0, 1, At, B1); PG8_BAR;
            PG8_LDA(At, 0, 1); PG8_STAGE(PG8_SA(0, 0), a2, voffA);
            PG8_BAR; PG8_WAIT_L(0); PG8_MMA(1, 0, At, B0); PG8_BAR; PG8_SCHED;
            PG8_STAGE(PG8_SB(0, 1), b2 + hsB, voffB);
            PG8_WAIT_V(6); PG8_BAR; PG8_MMA(1, 1, At, B1); PG8_BAR;
            PG8_LDB(B0, 1, 0); PG8_SCHED; PG8_LDA(At, 1, 0); PG8_STAGE(PG8_SA(0, 1), a2 + hsA, voffA);
            PG8_WAIT_L(8); PG8_BAR; PG8_WAIT_L(0); PG8_MMA(0, 0, At, B0); PG8_BAR; PG8_SCHED;
            PG8_LDB(B1, 1, 1); PG8_STAGE(PG8_SB(1, 0), b3, voffB);
            PG8_BAR; PG8_WAIT_L(0); PG8_MMA(0, 1, At, B1); PG8_BAR;
            PG8_LDA(At, 1, 1); PG8_STAGE(PG8_SA(1, 0), a3, voffA);
            PG8_BAR; PG8_WAIT_L(0); PG8_MMA(1, 0, At, B0); PG8_BAR; PG8_SCHED;
            PG8_STAGE(PG8_SB(1, 1), b3 + hsB, voffB);
            PG8_WAIT_V(6); PG8_BAR; PG8_MMA(1, 1, At, B1); PG8_BAR;
        }
        E(acc, cur, wr, wc, fr, fq);
        if (!has_next) break;
#pragma unroll
        for (int a = 0; a < 2; ++a)
#pragma unroll
            for (int b = 0; b < 2; ++b)
#pragma unroll
                for (int m = 0; m < 4; ++m)
#pragma unroll
                    for (int n = 0; n < 2; ++n) acc[a][b][m][n] = (f32x4){0.f, 0.f, 0.f, 0.f};
        cur = nxt; cA = nA; cB = nB; ++ui;
    }
    PG8_WAIT_V(0);
    if (wr == 0) PG8_BAR;
    PG8_BAR;
#undef PG8_SA
#undef PG8_SB
#undef PG8_STAGE
#undef PG8_LDA
#undef PG8_LDB
#undef PG8_MMA
#undef PG8_WAIT_V
#undef PG8_WAIT_L
#undef PG8_BAR
#undef PG8_SCHED
}
struct EpiProj {
    bf16_t* P; const float* rstd;
    __device__ __forceinline__ void operator()(const f32x4 (&acc)[2][2][4][2], const Unit& u, int wr, int wc, int fr, int fq) const {
        const int row0 = u.pm * BM + wr * 64 + fr, col0 = u.pn * BM + wc * 32 + 8 * fq;
#pragma unroll
        for (int ai = 0; ai < 2; ++ai)
#pragma unroll
            for (int m = 0; m < 4; ++m) { const int r = row0 + ai * HALF + m * 16; const float rs = rstd[r]; bf16_t* rowp = P + (size_t)r * NPROJ + col0;
#pragma unroll
                for (int bj = 0; bj < 2; ++bj) { if (col0 + bj * HALF < NPROJ) { const f32x4 v0 = acc[ai][bj][m][0] * rs, v1 = acc[ai][bj][m][1] * rs;
                    u32x4 o; o.x = pk_bf16(v0[0], v0[1]); o.y = pk_bf16(v0[2], v0[3]); o.z = pk_bf16(v1[0], v1[1]); o.w = pk_bf16(v1[2], v1[3]);
                    *(u32x4*)(rowp + bj * HALF) = o; } } }
    }
};
struct EpiResid {
    float* X; bf16_t* XB;
    __device__ __forceinline__ void operator()(const f32x4 (&acc)[2][2][4][2], const Unit& u, int wr, int wc, int fr, int fq) const {
        const int row0 = u.pm * BM + wr * 64 + fr, col0 = u.pn * BM + wc * 32 + 8 * fq;
#pragma unroll
        for (int ai = 0; ai < 2; ++ai)
#pragma unroll
            for (int m = 0; m < 4; ++m) { const size_t off = (size_t)(row0 + ai * HALF + m * 16) * DM + col0;
#pragma unroll
                for (int bj = 0; bj < 2; ++bj) { float* xp = X + off + bj * HALF;
                    const f32x4 v0 = *(const f32x4*)xp + acc[ai][bj][m][0], v1 = *(const f32x4*)(xp + 4) + acc[ai][bj][m][1];
                    *(f32x4*)xp = v0; *(f32x4*)(xp + 4) = v1;
                    u32x4 o; o.x = pk_bf16(v0[0], v0[1]); o.y = pk_bf16(v0[2], v0[3]); o.z = pk_bf16(v1[0], v1[1]); o.w = pk_bf16(v1[2], v1[3]);
                    *(u32x4*)(XB + off + bj * HALF) = o; }
                asm volatile("" ::: "memory"); }
    }
};
struct EpiF32 {
    float* C; int ldc;
    __device__ __forceinline__ void operator()(const f32x4 (&acc)[2][2][4][2], const Unit& u, int wr, int wc, int fr, int fq) const {
        const int row0 = u.pm * BM + wr * 64 + fr, col0 = u.pn * BM + wc * 32 + 8 * fq;
#pragma unroll
        for (int ai = 0; ai < 2; ++ai)
#pragma unroll
            for (int m = 0; m < 4; ++m) { float* rowp = C + (size_t)(row0 + ai * HALF + m * 16) * ldc + col0;
#pragma unroll
                for (int bj = 0; bj < 2; ++bj) { *(f32x4*)(rowp + bj * HALF) = acc[ai][bj][m][0]; *(f32x4*)(rowp + bj * HALF + 4) = acc[ai][bj][m][1]; } }
    }
};
}

struct Args { const float* in[26]; float* out; unsigned char* ws; int lo, hi; };
enum { I_X = 0, I_NMIX, I_NFFN, I_NFIN, I_WIN, I_WOUT, I_GCONV, I_GALOG, I_GDT, I_GNORM, I_HLB, I_HNORM, I_LCONVW, I_LCONVB, I_LWA, I_LBA, I_LWX, I_LBX, I_LLAM,
       I_DWG, I_DBG, I_DNORM, I_PWQ, I_PKEYS, I_PU, I_PV };
constexpr int NTHREADS = 512, NWAVES = 8;
constexpr int LDS_MISC = pg8::STAGE_BYTES;
constexpr int LDS_BYTES = pg8::STAGE_BYTES + 64;

__device__ __forceinline__ int win_srccol(int d) {
    if (d < 1536) return d;
    if (d < 3072) return d + 520;
    if (d < 3584) return d + 1032;
    if (d < 4608) return d + 1544;
    if (d < 5120) return d - 3072;
    if (d < 5632) return d - 1528;
    if (d < 6144) return d - 1016;
    if (d < 6656) return d + 8;
    if (d < 6664) return d - 4608;
    if (d < 6680) return d;
    return -1;
}
template <int MAP>
__device__ __forceinline__ void p0_transpose_item(const float* W, int K, int ldw, int nblk, bf16_t* WT, const float* rowscale, LAS float* scr, int item, int lane) {
    const int kb = item / nblk, nb = item % nblk, k0 = 64 * kb, n0 = 32 * nb;
    int sc = n0 + (lane & 31);
    if (MAP == 1) sc = win_srccol(sc);
#pragma unroll 8
    for (int i = 0; i < 32; ++i) { const int kk = 2 * i + (lane >> 5);
        float v = 0.f;
        if (sc >= 0) { v = W[(size_t)(k0 + kk) * ldw + sc]; if (rowscale) v *= rowscale[k0 + kk]; }
        scr[kk * 33 + (lane & 31)] = v; }
    asm volatile("s_waitcnt lgkmcnt(0)" ::: "memory");
    const int c = lane & 7;
#pragma unroll
    for (int j = 0; j < 4; ++j) { const int n = (lane >> 3) + 8 * j; const LAS float* s = scr + (8 * c) * 33 + n;
        u32x4 o; o.x = pk_bf16(s[0 * 33], s[1 * 33]); o.y = pk_bf16(s[2 * 33], s[3 * 33]); o.z = pk_bf16(s[4 * 33], s[5 * 33]); o.w = pk_bf16(s[6 * 33], s[7 * 33]);
        *(u32x4*)(WT + (size_t)(n0 + n) * K + k0 + 8 * c) = o; }
    asm volatile("s_waitcnt lgkmcnt(0)" ::: "memory");
}
__device__ __forceinline__ void convert_table(const float* src, bf16_t* dst, size_t n, int gtid, int gthreads) {
    const size_t n8 = n / 8;
    for (size_t i = gtid; i < n8; i += gthreads) { const f32x4 a = *(const f32x4*)(src + i * 8), b = *(const f32x4*)(src + i * 8 + 4);
        u32x4 o; o.x = pk_bf16(a[0], a[1]); o.y = pk_bf16(a[2], a[3]); o.z = pk_bf16(b[0], b[1]); o.w = pk_bf16(b[2], b[3]);
        *(u32x4*)(dst + i * 8) = o; }
}
__device__ __forceinline__ void p0_prologue(const Args& A, LAS unsigned char* lds) {
    const int tid = threadIdx.x, lane = tid & 63, wave = __builtin_amdgcn_readfirstlane(tid >> 6), G = gridDim.x, bx = blockIdx.x;
    const int gw = bx * NWAVES + wave, NGW = G * NWAVES;
    unsigned char* ws = A.ws;
    {
        float* X = A.out; bf16_t* XB = (bf16_t*)(ws + WS_XB); float* rstd1 = (float*)(ws + WS_RSTD1);
        for (int row = gw; row < MTOK; row += NGW) {
            const f32x4* xr = (const f32x4*)(A.in[I_X] + (size_t)row * DM) + lane; f32x4 v[4]; float s = 0.f;
#pragma unroll
            for (int j = 0; j < 4; ++j) { v[j] = xr[64 * j]; s += (v[j].x * v[j].x + v[j].y * v[j].y) + (v[j].z * v[j].z + v[j].w * v[j].w); }
            s = wave_sum64(s);
            f32x4* xo = (f32x4*)(X + (size_t)row * DM) + lane; u32x2* bo = (u32x2*)(XB + (size_t)row * DM) + lane;
#pragma unroll
            for (int j = 0; j < 4; ++j) { xo[64 * j] = v[j]; u32x2 o; o.x = pk_bf16(v[j].x, v[j].y); o.y = pk_bf16(v[j].z, v[j].w); bo[64 * j] = o; }
            if (lane == 0) rstd1[row] = rsqrtf(s * (1.f / DM) + EPS);
        }
    }
    {
        LAS float* scr = (LAS float*)(lds + wave * 8704);
        constexpr int NB_IN = NPROJP / 32, I_IN = (DM / 64) * NB_IN, NB_OUT = DM / 32, I_OUT = (2048 / 64) * NB_OUT;
        constexpr int NITEMS = NLAYER * (I_IN + I_OUT);
        for (int it = gw; it < NITEMS; it += NGW) {
            int r = it; const int l = r / (I_IN + I_OUT); r -= l * (I_IN + I_OUT);
            if (r < I_IN) p0_transpose_item<1>(A.in[I_WIN] + (size_t)l * DM * NPROJ, DM, NPROJ, NB_IN, (bf16_t*)(ws + WS_WIN) + (size_t)l * NPROJP * DM, A.in[I_NMIX] + l * DM, scr, r, lane);
            else p0_transpose_item<0>(A.in[I_WOUT] + (size_t)l * 2048 * DM, 2048, DM, NB_OUT, (bf16_t*)(ws + WS_WOUT) + (size_t)l * DM * 2048, nullptr, scr, r - I_IN, lane);
        }
    }
    __syncthreads();
    {
        LAS float* key_s = (LAS float*)lds; LAS float* wq_s = key_s + 128 * 129;
        for (int it = bx; it < NLAYER * 16 * 16; it += G) {
            const int l = it >> 8, hp = (it >> 4) & 15, k0 = (it & 15) * 64;
            const float* keys = A.in[I_PKEYS] + ((size_t)l * 16 + hp) * 128 * 128;
            const float* wq = A.in[I_PWQ] + (size_t)l * DM * 2048 + (size_t)k0 * 2048 + hp * 128;
            for (int e = tid; e < 128 * 128; e += NTHREADS) key_s[(e >> 7) * 129 + (e & 127)] = keys[e];
            for (int e = tid; e < 64 * 128; e += NTHREADS) wq_s[(e >> 7) * 129 + (e & 127)] = wq[(size_t)(e >> 7) * 2048 + (e & 127)];
            __syncthreads();
            const int ks = (tid & 15) * 4, ys = (tid >> 4) * 4;
            float acc[4][4];
#pragma unroll
            for (int i = 0; i < 4; ++i)
#pragma unroll
                for (int j = 0; j < 4; ++j) acc[i][j] = 0.f;
            for (int d = 0; d < 128; ++d) { float a[4], b[4];
#pragma unroll
                for (int i = 0; i < 4; ++i) { a[i] = wq_s[(ks + i) * 129 + d]; b[i] = key_s[(ys + i) * 129 + d]; }
#pragma unroll
                for (int i = 0; i < 4; ++i)
#pragma unroll
                    for (int j = 0; j < 4; ++j) acc[i][j] += a[i] * b[j]; }
            const float* nf = A.in[I_NFFN] + l * DM + k0 + ks;
            bf16_t* wt = (bf16_t*)(ws + WS_WEFF) + (size_t)l * 2048 * DM;
#pragma unroll
            for (int j = 0; j < 4; ++j) { u32x2 o; o.x = pk_bf16(acc[0][j] * nf[0], acc[1][j] * nf[1]); o.y = pk_bf16(acc[2][j] * nf[2], acc[3][j] * nf[3]);
                *(u32x2*)(wt + (size_t)(hp * 128 + ys + j) * DM + k0 + ks) = o; }
            __syncthreads();
        }
    }
    {
        bf16_t* wt = (bf16_t*)(ws + WS_LRUW);
        for (int e = bx * NTHREADS + tid; e < NLAYER * 2 * 4 * 128 * 128; e += G * NTHREADS) {
            const int k = e & 127, n = (e >> 7) & 127, g = (e >> 14) & 3, mat = (e >> 16) & 1, l = e >> 17;
            const float* src = A.in[mat ? I_LWX : I_LWA] + (((size_t)l * 4 + g) * 128 + k) * 128 + n;
            wt[e] = to_bf1(*src);
        }
    }
}

__device__ __forceinline__ void convert_tables(const Args& A, int l) {
    const int tid = threadIdx.x, lane = tid & 63, wave = __builtin_amdgcn_readfirstlane(tid >> 6), G = gridDim.x, bx = blockIdx.x;
    const int gw = bx * NWAVES + wave, NGW = G * NWAVES;
    unsigned char* ws = A.ws;
    for (int row = gw; row < 2 * 16384; row += NGW) {
        const int tbl = row >> 14, rr = row & 16383;
        const float* src = A.in[tbl ? I_PV : I_PU] + ((size_t)l * 16384 + rr) * DM + 16 * lane;
        f32x4 v[4]; float mx = 0.f;
#pragma unroll
        for (int j = 0; j < 4; ++j) { v[j] = *(const f32x4*)(src + 4 * j); mx = fmaxf(fmaxf(mx, fmaxf(fabsf(v[j].x), fabsf(v[j].y))), fmaxf(fabsf(v[j].z), fabsf(v[j].w))); }
        mx = fmaxf(mx, dpp_f<0x128>(mx)); mx = fmaxf(mx, dpp_f<0x124>(mx)); mx = fmaxf(mx, dpp_f<0x122>(mx)); mx = fmaxf(mx, dpp_f<0x121>(mx));
        mx = fmaxf(fmaxf(rdlane(mx, 0), rdlane(mx, 16)), fmaxf(rdlane(mx, 32), rdlane(mx, 48)));
        mx = fmaxf(mx, 1e-30f);
        const float sc = 6.f / mx;
        u32x2 o; unsigned p;
        p = 0u; p = __builtin_amdgcn_cvt_scalef32_pk_fp4_f32(p, v[0].x * sc, v[0].y * sc, 1.0f, 0); p = __builtin_amdgcn_cvt_scalef32_pk_fp4_f32(p, v[0].z * sc, v[0].w * sc, 1.0f, 1);
        p = __builtin_amdgcn_cvt_scalef32_pk_fp4_f32(p, v[1].x * sc, v[1].y * sc, 1.0f, 2); p = __builtin_amdgcn_cvt_scalef32_pk_fp4_f32(p, v[1].z * sc, v[1].w * sc, 1.0f, 3); o.x = p;
        p = 0u; p = __builtin_amdgcn_cvt_scalef32_pk_fp4_f32(p, v[2].x * sc, v[2].y * sc, 1.0f, 0); p = __builtin_amdgcn_cvt_scalef32_pk_fp4_f32(p, v[2].z * sc, v[2].w * sc, 1.0f, 1);
        p = __builtin_amdgcn_cvt_scalef32_pk_fp4_f32(p, v[3].x * sc, v[3].y * sc, 1.0f, 2); p = __builtin_amdgcn_cvt_scalef32_pk_fp4_f32(p, v[3].z * sc, v[3].w * sc, 1.0f, 3); o.y = p;
        *(u32x2*)(ws + (tbl ? WS_V8 : WS_U8) + (size_t)rr * (DM / 2) + 8 * lane) = o;
        if (lane == 0) ((float*)(ws + (tbl ? WS_SV : WS_SU)))[rr] = mx * (1.f / 6.f);
    }
}

__device__ __forceinline__ void load8(const bf16_t* p, float (&f)[8]) { unpack8(*(const u32x4*)p, f); }
__device__ __forceinline__ float hgrn_lb(const Args& A, int l, int c) {
    if (l == 0) return 0.f;
    const float* lg = A.in[I_HLB]; return sigmoidf_(lg[512 + c] - lg[c]);
}
typedef bf16x8 frag_t;
#define MFMA16(a_, b_, c_) __builtin_amdgcn_mfma_f32_16x16x32_bf16((a_), (b_), (c_), 0, 0, 0)
constexpr int XCS = 520;
constexpr int P136 = 136, P72 = 72, P68 = 68;
constexpr int LDS_SMALL = 122880;
template <int DK>
__device__ __forceinline__ void k1_gla_head(const Args& A, LAS unsigned char* lds, int l, int h, int r0, int ci, bf16_t* proj, unsigned char* aux) {
    constexpr bool HG = (DK == 128);
    constexpr int NSEG = NTHREADS / DK, TPS = 64 / NSEG, PD = DK + 8;
    const int tid = threadIdx.x, lane = tid & 63, wave = __builtin_amdgcn_readfirstlane(tid >> 6), c = tid % DK, seg = tid / DK;
    LAS bf16_t* Q1L = (LAS bf16_t*)lds; LAS bf16_t* K1L = Q1L + 64 * PD; LAS float* segsum = (LAS float*)(K1L + 64 * PD);
    const int qcol = (HG ? C_BQ : C_DQ) + h * DK + c, kcol = (HG ? C_BF : C_DK) + h * DK + c;
    float lbv = 0.f, wg[16], bgv = 0.f;
    if (HG) lbv = hgrn_lb(A, l, h * 128 + c);
    else { const float* wgp = A.in[I_DWG] + (size_t)l * 16 * 256 + h * 64 + c;
#pragma unroll
        for (int r = 0; r < 16; ++r) wg[r] = wgp[r * 256];
        bgv = A.in[I_DBG][l * 256 + h * 64 + c]; }
    LAS bf16_t* LRL = (LAS bf16_t*)(segsum + NSEG * DK);
    {
        constexpr int CPR = DK / 8, NPT = 64 * CPR / NTHREADS;
#pragma unroll
        for (int i = 0; i < NPT; ++i) { const int e = tid + i * NTHREADS, r = e / CPR, cc = (e % CPR) * 8; const bf16_t* pr = proj + (size_t)(r0 + r) * NPROJ;
            *(LAS u32x4*)(Q1L + r * PD + cc) = *(const u32x4*)(pr + (HG ? C_BQ : C_DQ) + h * DK + cc);
            *(LAS u32x4*)(K1L + r * PD + cc) = *(const u32x4*)(pr + (HG ? C_BF : C_DK) + h * DK + cc); }
        if (!HG && tid < 128) { const int r = tid >> 1, cc = (tid & 1) * 8; *(LAS u32x4*)(LRL + r * 16 + cc) = *(const u32x4*)(proj + (size_t)(r0 + r) * NPROJ + C_DLR + cc); }
    }
    __syncthreads();
#define K1_TOKEN(t_, qv_, kv_, lg_) do { const float qr_ = bf1(Q1L[(t_) * PD + c]), kr_ = bf1(K1L[(t_) * PD + c]); \
        if (HG) { qv_ = siluf_(qr_); kv_ = (1.f - lbv) * sigmoidf_(-kr_); lg_ = log1pf(-kv_); } \
        else { qv_ = qr_; kv_ = kr_; float t8_[8]; float z_ = bgv; unpack8(*(const LAS u32x4*)(LRL + (t_) * 16), t8_); \
            _Pragma("unroll") for (int r_ = 0; r_ < 8; ++r_) z_ = fmaf(t8_[r_], wg[r_], z_); \
            unpack8(*(const LAS u32x4*)(LRL + (t_) * 16 + 8), t8_); \
            _Pragma("unroll") for (int r_ = 0; r_ < 8; ++r_) z_ = fmaf(t8_[r_], wg[8 + r_], z_); \
            lg_ = -softplusf_(-z_) * (1.f / 16.f); } } while (0)
    {
        float run = 0.f;
#pragma unroll 4
        for (int i = 0; i < TPS; ++i) { float qv, kv, lg; K1_TOKEN(seg * TPS + i, qv, kv, lg); run += lg; asm volatile("" :: "v"(qv), "v"(kv)); }
        segsum[seg * DK + c] = run;
    }
    __syncthreads();
    float off = 0.f, bref = 0.f, blast = 0.f;
#pragma unroll
    for (int s2 = 0; s2 < NSEG; ++s2) { const float v = segsum[s2 * DK + c]; if (s2 < seg) off += v; if (s2 < NSEG / 2) bref += v; blast += v; }
    {
        bf16_t* ktp = (bf16_t*)(aux + (HG ? AX_HKT : AX_DKT)) + ((size_t)ci * DK + c) * 64 + seg * TPS;
        float run = off;
#pragma unroll 1
        for (int i8 = 0; i8 < TPS; i8 += 8) { float k2[8];
#pragma unroll
            for (int i = 0; i < 8; ++i) { const int t = seg * TPS + i8 + i; float qv, kv, lg; K1_TOKEN(t, qv, kv, lg); run += lg; const float b = run;
                Q1L[t * PD + c] = to_bf1(qv * __expf(b - bref)); K1L[t * PD + c] = to_bf1(kv * __expf(bref - b));
                proj[(size_t)(r0 + t) * NPROJ + qcol] = to_bf1(qv * __expf(b));
                k2[i] = kv * __expf(blast - b); }
            u32x4 o; o.x = pk_bf16(k2[0], k2[1]); o.y = pk_bf16(k2[2], k2[3]); o.z = pk_bf16(k2[4], k2[5]); o.w = pk_bf16(k2[6], k2[7]); *(u32x4*)(ktp + i8) = o; }
        if (seg == 0) ((float*)(aux + (HG ? AX_HGD : AX_DGD)))[(size_t)ci * DK + c] = __expf(blast);
    }
#undef K1_TOKEN
    __syncthreads();
    {
        const int fr = lane & 15, fq = lane >> 4;
        bf16_t* att = (bf16_t*)(aux + (HG ? AX_HATT : AX_DATT)) + (size_t)ci * 64 * 64;
#pragma unroll
        for (int tt = 0; tt < 2; ++tt) { const int id = wave * 2 + tt, mi = id >> 2, nj = id & 3;
            f32x4 acc = {0.f, 0.f, 0.f, 0.f};
            if (nj <= mi) {
#pragma unroll
                for (int ks = 0; ks < DK / 32; ++ks) { const frag_t a = *(const LAS frag_t*)(Q1L + (mi * 16 + fr) * PD + ks * 32 + fq * 8), b = *(const LAS frag_t*)(K1L + (nj * 16 + fr) * PD + ks * 32 + fq * 8);
                    acc = MFMA16(a, b, acc); } }
#pragma unroll
            for (int r = 0; r < 4; ++r) { const int i = mi * 16 + fq * 4 + r, j = nj * 16 + fr; att[i * 64 + j] = to_bf1(j <= i ? acc[r] : 0.f); } }
    }
    __syncthreads();
}
__device__ __forceinline__ void b1_prep(const Args& A, LAS unsigned char* lds, int l, int half) {
    const int tid = threadIdx.x, lane = tid & 63, wave = __builtin_amdgcn_readfirstlane(tid >> 6), G = gridDim.x, fr = lane & 15, fq = lane >> 4;
    bf16_t* proj = (bf16_t*)(A.ws + WS_PROJ); unsigned char* aux = A.ws + WS_AUX;
    LAS bf16_t* xc = (LAS bf16_t*)lds;
    LAS float* sg = (LAS float*)(lds + LDS_SMALL);
    LAS float* sb = sg + 256;
    LAS float* sgc = sb + 256;
    for (int tile = blockIdx.x; tile < HM / 64; tile += G) {
        const int r0 = tile * 64, t0 = (tile & 63) * 64, bb = tile >> 6, chunk = tile & 63;
        for (int u = wave; u < 24; u += NWAVES) {
            const int p = u >> 3, ch = u & 7, c = p * 512 + lane * 8, ts = t0 + ch * 8, rs = r0 + ch * 8;
            const float* cwp = A.in[I_GCONV] + (size_t)l * 4 * 1536 + c;
            float cw[4][8];
#pragma unroll
            for (int w = 0; w < 4; ++w) { const f32x4 a = *(const f32x4*)(cwp + w * 1536), b = *(const f32x4*)(cwp + w * 1536 + 4);
                cw[w][0] = a[0]; cw[w][1] = a[1]; cw[w][2] = a[2]; cw[w][3] = a[3]; cw[w][4] = b[0]; cw[w][5] = b[1]; cw[w][6] = b[2]; cw[w][7] = b[3]; }
            float x3[8], x2[8], x1[8], x0[8];
            if (ts >= 3) { load8(proj + (size_t)(rs - 3) * NPROJ + c, x3); load8(proj + (size_t)(rs - 2) * NPROJ + c, x2); load8(proj + (size_t)(rs - 1) * NPROJ + c, x1); }
            else {
#pragma unroll
                for (int j = 0; j < 8; ++j) { x3[j] = 0.f; x2[j] = 0.f; x1[j] = 0.f; } }
            const int ci = (bb * 4 + (lane >> 4)) * 64 + chunk;
            bf16_t* dst = (bf16_t*)(aux + (p == 0 ? AX_GQ : (p == 1 ? AX_GW : AX_GO))) + ((size_t)ci * 64 + ch * 8) * 128 + (lane & 15) * 8;
#pragma unroll
            for (int i = 0; i < 8; ++i) {
                load8(proj + (size_t)(rs + i) * NPROJ + c, x0);
                float o[8]; float ss = 0.f;
#pragma unroll
                for (int j = 0; j < 8; ++j) { const float v = cw[0][j] * x3[j] + cw[1][j] * x2[j] + cw[2][j] * x1[j] + cw[3][j] * x0[j]; o[j] = siluf_(v); ss += o[j] * o[j]; }
                if (p < 2) { ss = row_sum16(ss); const float sc = rsqrtf(ss + EPS);
#pragma unroll
                    for (int j = 0; j < 8; ++j) o[j] *= sc; }
                *(u32x4*)(dst + (size_t)i * 128) = pack8(o);
#pragma unroll
                for (int j = 0; j < 8; ++j) { x3[j] = x2[j]; x2[j] = x1[j]; x1[j] = x0[j]; }
            }
        }
        if (tid < 256) { const int tk = tid & 63, h = tid >> 6; const size_t row = (size_t)(r0 + tk);
            const float a = bf1(proj[row * NPROJ + C_AA + h]), b = bf1(proj[row * NPROJ + C_AB + h]);
            sg[h * 64 + tk] = -__expf(A.in[I_GALOG][l * 4 + h]) * softplusf_(a + A.in[I_GDT][l * 4 + h]); sb[h * 64 + tk] = sigmoidf_(b); }
        { const int ch = wave, c = lane * 8, ts = t0 + ch * 8, rs = r0 + ch * 8;
            const float* cwp = A.in[I_LCONVW] + (size_t)l * 4 * 512 + c; const float* cbp = A.in[I_LCONVB] + l * 512 + c;
            float cw[4][8], cb[8];
#pragma unroll
            for (int w = 0; w < 4; ++w) { const f32x4 a = *(const f32x4*)(cwp + w * 512), b = *(const f32x4*)(cwp + w * 512 + 4);
                cw[w][0] = a[0]; cw[w][1] = a[1]; cw[w][2] = a[2]; cw[w][3] = a[3]; cw[w][4] = b[0]; cw[w][5] = b[1]; cw[w][6] = b[2]; cw[w][7] = b[3]; }
            { const f32x4 a = *(const f32x4*)cbp, b = *(const f32x4*)(cbp + 4); cb[0] = a[0]; cb[1] = a[1]; cb[2] = a[2]; cb[3] = a[3]; cb[4] = b[0]; cb[5] = b[1]; cb[6] = b[2]; cb[7] = b[3]; }
            float x3[8], x2[8], x1[8], x0[8];
            const bf16_t* src = proj + C_CX + c;
            if (ts >= 3) { load8(src + (size_t)(rs - 3) * NPROJ, x3); load8(src + (size_t)(rs - 2) * NPROJ, x2); load8(src + (size_t)(rs - 1) * NPROJ, x1); }
            else {
#pragma unroll
                for (int j = 0; j < 8; ++j) { x3[j] = 0.f; x2[j] = 0.f; x1[j] = 0.f; } }
#pragma unroll
            for (int i = 0; i < 8; ++i) {
                load8(src + (size_t)(rs + i) * NPROJ, x0);
                float o[8];
#pragma unroll
                for (int j = 0; j < 8; ++j) o[j] = cb[j] + cw[0][j] * x3[j] + cw[1][j] * x2[j] + cw[2][j] * x1[j] + cw[3][j] * x0[j];
                *(LAS u32x4*)(xc + (ch * 8 + i) * XCS + c) = pack8(o);
#pragma unroll
                for (int j = 0; j < 8; ++j) { x3[j] = x2[j]; x2[j] = x1[j]; x1[j] = x0[j]; }
            }
        }
        __syncthreads();
        { const int g = wave >> 1, nh = wave & 1;
            const bf16_t* wa = (const bf16_t*)(A.ws + WS_LRUW) + (((size_t)l * 2 + 0) * 4 + g) * 128 * 128;
            const bf16_t* wx = (const bf16_t*)(A.ws + WS_LRUW) + (((size_t)l * 2 + 1) * 4 + g) * 128 * 128;
            bf16_t* lom = (bf16_t*)(aux + AX_LOM); bf16_t* lbb = (bf16_t*)(aux + AX_LB);
#pragma unroll 1
            for (int nt = 0; nt < 4; ++nt) {
                const int n = nh * 64 + nt * 16 + fr, cch = g * 128 + n;
                frag_t ba[4], bx[4];
#pragma unroll
                for (int ks = 0; ks < 4; ++ks) { ba[ks] = *(const frag_t*)(wa + (size_t)n * 128 + ks * 32 + fq * 8); bx[ks] = *(const frag_t*)(wx + (size_t)n * 128 + ks * 32 + fq * 8); }
                const float b_a = A.in[I_LBA][l * 512 + cch], b_x = A.in[I_LBX][l * 512 + cch], spl = softplusf_(-A.in[I_LLAM][l * 512 + cch]);
#pragma unroll 1
                for (int m = 0; m < 4; ++m) {
                    f32x4 ca = {0.f, 0.f, 0.f, 0.f}, cx = {0.f, 0.f, 0.f, 0.f};
#pragma unroll
                    for (int ks = 0; ks < 4; ++ks) { const frag_t af = *(const LAS frag_t*)(xc + (m * 16 + fr) * XCS + g * 128 + ks * 32 + fq * 8);
                        ca = MFMA16(af, ba[ks], ca); cx = MFMA16(af, bx[ks], cx); }
#pragma unroll
                    for (int j = 0; j < 4; ++j) { const int tk = m * 16 + fq * 4 + j;
                        const float r = sigmoidf_(ca[j] + b_a), ig = sigmoidf_(cx[j] + b_x), la = -8.f * r * spl;
                        const float om = -expm1f(la), mult = sqrtf(-expm1f(2.f * la)), xv = bf1(xc[tk * XCS + cch]);
                        lom[(size_t)(r0 + tk) * 512 + cch] = to_bf1(om); lbb[(size_t)(r0 + tk) * 512 + cch] = to_bf1(mult * ig * xv); }
                }
            }
        }
        __syncthreads();
        for (int h = 0; h < 4; ++h) k1_gla_head<128>(A, lds, l, h, r0, (bb * 4 + h) * 64 + chunk, proj, aux);
        for (int h = 0; h < 4; ++h) k1_gla_head<64>(A, lds, l, h, r0, (bb * 4 + h) * 64 + chunk, proj, aux);
        LAS bf16_t* kL = (LAS bf16_t*)lds;
        LAS bf16_t* qL = kL + 64 * P136;
        LAS float* AL = (LAS float*)(lds + 36864);
        float gcv = 0.f;
        if (tid < 256) { const int tk = tid & 63, h = tid >> 6;
            for (int s2 = 0; s2 < 64; ++s2) { const float v = sg[h * 64 + s2]; gcv += (s2 <= tk) ? v : 0.f; } }
        __syncthreads();
        if (tid < 256) sg[tid] = gcv;
        __syncthreads();
        for (int h = 0; h < 4; ++h) {
            const int ci = (bb * 4 + h) * 64 + chunk;
            bf16_t* gq = (bf16_t*)(aux + AX_GQ) + (size_t)ci * 64 * 128; const bf16_t* gk = (const bf16_t*)(aux + AX_GW) + (size_t)ci * 64 * 128;
            bf16_t* gkt = (bf16_t*)(aux + AX_GKT) + (size_t)ci * 128 * 64;
            const float glast = sg[h * 64 + 63];
#pragma unroll
            for (int e2 = 0; e2 < 2; ++e2) { const int e = tid + e2 * NTHREADS, t = e & 63, dc = (e >> 6) * 8; const float gct = sg[h * 64 + t];
                const u32x4 kr = *(const u32x4*)(gk + t * 128 + dc), qr = *(const u32x4*)(gq + t * 128 + dc);
                *(LAS u32x4*)(kL + t * P136 + dc) = kr; *(LAS u32x4*)(qL + t * P136 + dc) = qr;
                float kf[8], qf[8]; unpack8(kr, kf); unpack8(qr, qf);
                const float eg = __expf(gct), ek = __expf(glast - gct);
#pragma unroll
                for (int j = 0; j < 8; ++j) { gkt[(dc + j) * 64 + t] = to_bf1(kf[j] * ek); qf[j] *= eg; }
                *(u32x4*)(gq + t * 128 + dc) = pack8(qf); }
            if (tid == 0) ((float*)(aux + AX_GGL))[ci] = __expf(glast);
            __syncthreads();
            { bf16_t* gqk = (bf16_t*)(aux + AX_GQK) + (size_t)ci * 64 * 64; LAS float* ALh = AL + h * 64 * P68;
#pragma unroll
                for (int tt = 0; tt < 2; ++tt) { const int id = wave * 2 + tt, mi = id >> 2, nj = id & 3;
                    f32x4 ak = {0.f, 0.f, 0.f, 0.f}, aq = {0.f, 0.f, 0.f, 0.f};
                    if (nj <= mi) {
#pragma unroll
                        for (int ks = 0; ks < 4; ++ks) { const frag_t ka = *(const LAS frag_t*)(kL + (mi * 16 + fr) * P136 + ks * 32 + fq * 8), qa = *(const LAS frag_t*)(qL + (mi * 16 + fr) * P136 + ks * 32 + fq * 8),
                                kb = *(const LAS frag_t*)(kL + (nj * 16 + fr) * P136 + ks * 32 + fq * 8);
                            ak = MFMA16(ka, kb, ak); aq = MFMA16(qa, kb, aq); } }
                    const int j = nj * 16 + fr; const float gj = sg[h * 64 + j];
#pragma unroll
                    for (int r = 0; r < 4; ++r) { const int i = mi * 16 + fq * 4 + r; const float dec = __expf(fminf(sg[h * 64 + i] - gj, 0.f));
                        ALh[i * P68 + j] = (j < i) ? sb[h * 64 + i] * ak[r] * dec : 0.f;
                        gqk[i * 64 + j] = to_bf1(j <= i ? aq[r] * dec : 0.f); } }
            }
            __syncthreads();
        }
        if (wave < 4) { LAS float* ALh = AL + wave * 64 * P68;
            float T[64];
#pragma unroll
            for (int i = 0; i < 64; ++i) { int li = lane; asm volatile("" : "+v"(li)); float a0 = (li == i) ? 1.f : 0.f, a1 = 0.f;
#pragma unroll
                for (int m4 = 0; m4 < i; m4 += 4) { const f32x4 av = *(const LAS f32x4*)(ALh + i * P68 + m4);
                    a0 = fmaf(-av[0], T[m4], a0);
                    if (m4 + 1 < i) a1 = fmaf(-av[1], T[m4 + 1], a1);
                    if (m4 + 2 < i) a0 = fmaf(-av[2], T[m4 + 2], a0);
                    if (m4 + 3 < i) a1 = fmaf(-av[3], T[m4 + 3], a1); }
                T[i] = a0 + a1; }
            asm volatile("s_waitcnt lgkmcnt(0)" ::: "memory");
            LAS bf16_t* TLh = (LAS bf16_t*)ALh;
#pragma unroll
            for (int i = 0; i < 64; ++i) TLh[i * P72 + lane] = to_bf1(T[i]);
        }
        __syncthreads();
        LAS bf16_t* XT = kL; LAS bf16_t* VT = XT + 128 * P72;
        for (int h = 0; h < 4; ++h) {
            const int ci = (bb * 4 + h) * 64 + chunk;
            bf16_t* gw = (bf16_t*)(aux + AX_GW) + (size_t)ci * 64 * 128; const bf16_t* gv = (const bf16_t*)(aux + AX_GO) + (size_t)ci * 64 * 128;
            bf16_t* gut = (bf16_t*)(aux + AX_GUT) + (size_t)ci * 128 * 64;
#pragma unroll
            for (int e2 = 0; e2 < 2; ++e2) { const int e = tid + e2 * NTHREADS, t = e & 63, dc = (e >> 6) * 8; const float bt = sb[h * 64 + t], bx = bt * __expf(sg[h * 64 + t]);
                float kf[8], vf[8]; load8(gw + t * 128 + dc, kf); load8(gv + t * 128 + dc, vf);
#pragma unroll
                for (int j = 0; j < 8; ++j) { XT[(dc + j) * P72 + t] = to_bf1(kf[j] * bx); VT[(dc + j) * P72 + t] = to_bf1(vf[j] * bt); } }
            __syncthreads();
            { const LAS bf16_t* TLh = (const LAS bf16_t*)(AL + h * 64 * P68);
#pragma unroll 1
                for (int tt = 0; tt < 4; ++tt) { const int id = wave * 4 + tt, mi = id >> 3, nd = id & 7;
                    f32x4 aw = {0.f, 0.f, 0.f, 0.f}, au = {0.f, 0.f, 0.f, 0.f};
#pragma unroll
                    for (int ks = 0; ks < 2; ++ks) { const frag_t ta = *(const LAS frag_t*)(TLh + (mi * 16 + fr) * P72 + ks * 32 + fq * 8), xb = *(const LAS frag_t*)(XT + (nd * 16 + fr) * P72 + ks * 32 + fq * 8),
                            vb = *(const LAS frag_t*)(VT + (nd * 16 + fr) * P72 + ks * 32 + fq * 8);
                        aw = MFMA16(ta, xb, aw); au = MFMA16(ta, vb, au); }
#pragma unroll
                    for (int r = 0; r < 4; ++r) gw[(mi * 16 + fq * 4 + r) * 128 + nd * 16 + fr] = to_bf1(aw[r]);
                    u32x2 o; o.x = pk_bf16(au[0], au[1]); o.y = pk_bf16(au[2], au[3]);
                    *(u32x2*)(gut + (nd * 16 + fr) * 64 + mi * 16 + fq * 4) = o; }
            }
            __syncthreads();
        }
    }
}

template <bool DELTA, int DK>
__device__ __forceinline__ void k2_unit(LAS unsigned char* lds, unsigned char* aux, bf16_t* proj, int bbh) {
    constexpr int PD = DK + 8, MT = DK / 16, KS = DK / 32;
    constexpr bool HG = (DK == 128);
    const int tid = threadIdx.x, lane = tid & 63, wave = __builtin_amdgcn_readfirstlane(tid >> 6), fr = lane & 15, fq = lane >> 4;
    LAS bf16_t* sA1 = (LAS bf16_t*)lds;
    LAS bf16_t* sA2 = sA1 + 64 * PD;
    constexpr int PD2 = DELTA ? PD : P136;
    LAS bf16_t* sKT = sA2 + 64 * PD2;
    LAS bf16_t* sAT = sKT + DK * P72;
    LAS float* sGD = (LAS float*)(sAT + 64 * P72);
    LAS bf16_t* pS = (LAS bf16_t*)(sGD + 128) + (wave & 3) * (32 * PD + 32 * P72);
    LAS bf16_t* pX = pS + 32 * PD;
    const int bb = bbh >> 2, h = bbh & 3;
    const size_t ci0 = (size_t)bbh * 64;
    const bf16_t* gA1; const bf16_t* gA2; const bf16_t* gKT; const bf16_t* gAT; const float* gGD; size_t a1ld, a2ld, a1cs, a2cs;
    if (DELTA) { gA1 = (const bf16_t*)(aux + AX_GW) + ci0 * 8192; gA2 = (const bf16_t*)(aux + AX_GQ) + ci0 * 8192; a1ld = 128; a2ld = 128; a1cs = 8192; a2cs = 8192;
        gKT = (const bf16_t*)(aux + AX_GKT) + ci0 * 8192; gAT = (const bf16_t*)(aux + AX_GQK) + ci0 * 4096; gGD = (const float*)(aux + AX_GGL) + ci0; }
    else { gA1 = proj + (size_t)bb * SEQ * NPROJ + (HG ? C_BQ : C_DQ) + h * DK; gA2 = proj + (size_t)bb * SEQ * NPROJ + (HG ? C_BI : C_DV) + h * 128; a1ld = NPROJ; a2ld = NPROJ; a1cs = (size_t)64 * NPROJ; a2cs = (size_t)64 * NPROJ;
        gKT = (const bf16_t*)(aux + (HG ? AX_HKT : AX_DKT)) + ci0 * DK * 64; gAT = (const bf16_t*)(aux + (HG ? AX_HATT : AX_DATT)) + ci0 * 4096; gGD = (const float*)(aux + (HG ? AX_HGD : AX_DGD)) + ci0 * DK; }
    constexpr int N1 = 64 * DK / 8 / 256, N2 = DELTA ? N1 : 4, NK = DK * 8 / 256, NA = 2;
    u32x4 r1[N1], r2[N2], rk[NK], ra[NA]; float rg = 0.f;
    const int st = tid - 256;
#define K2_GLOAD(c_) do { if (wave >= 4) { \
        _Pragma("unroll") for (int i = 0; i < N1; ++i) { const int e = st + i * 256, r = e / (DK / 8), cc = (e % (DK / 8)) * 8; r1[i] = *(const u32x4*)(gA1 + (size_t)(c_) * a1cs + (size_t)r * a1ld + cc); } \
        _Pragma("unroll") for (int i = 0; i < N2; ++i) { const int e = st + i * 256, r = DELTA ? e / (DK / 8) : e / 16, cc = (DELTA ? e % (DK / 8) : e % 16) * 8; r2[i] = *(const u32x4*)(gA2 + (size_t)(c_) * a2cs + (size_t)r * a2ld + cc); } \
        _Pragma("unroll") for (int i = 0; i < NK; ++i) { const int e = st + i * 256; rk[i] = *(const u32x4*)(gKT + (size_t)(c_) * DK * 64 + (size_t)e * 8); } \
        _Pragma("unroll") for (int i = 0; i < NA; ++i) { const int e = st + i * 256; ra[i] = *(const u32x4*)(gAT + (size_t)(c_) * 4096 + (size_t)e * 8); } \
        if (DELTA) { if (st == 0) rg = gGD[(c_)]; } else { if (st < DK) rg = gGD[(size_t)(c_) * DK + st]; } } } while (0)
#define K2_LSTORE() do { if (wave >= 4) { \
        _Pragma("unroll") for (int i = 0; i < N1; ++i) { const int e = st + i * 256, r = e / (DK / 8), cc = (e % (DK / 8)) * 8; *(LAS u32x4*)(sA1 + r * PD + cc) = r1[i]; } \
        _Pragma("unroll") for (int i = 0; i < N2; ++i) { const int e = st + i * 256, r = DELTA ? e / (DK / 8) : e / 16, cc = (DELTA ? e % (DK / 8) : e % 16) * 8; *(LAS u32x4*)(sA2 + r * PD2 + cc) = r2[i]; } \
        _Pragma("unroll") for (int i = 0; i < NK; ++i) { const int e = st + i * 256, r = e / 8, cc = (e % 8) * 8; *(LAS u32x4*)(sKT + r * P72 + cc) = rk[i]; } \
        _Pragma("unroll") for (int i = 0; i < NA; ++i) { const int e = st + i * 256, r = e / 8, cc = (e % 8) * 8; *(LAS u32x4*)(sAT + r * P72 + cc) = ra[i]; } \
        if (DELTA) { if (st == 0) sGD[0] = rg; } else { if (st < DK) sGD[st] = rg; } } } while (0)
    f32x4 accS[MT][2];
#pragma unroll
    for (int m = 0; m < MT; ++m) { accS[m][0] = (f32x4){0.f, 0.f, 0.f, 0.f}; accS[m][1] = (f32x4){0.f, 0.f, 0.f, 0.f}; }
    const int dv0 = wave * 32;
    const bf16_t* gUT = (const bf16_t*)(aux + AX_GUT) + ci0 * 8192;
    bf16_t* gO = DELTA ? (bf16_t*)(aux + AX_GO) + ci0 * 8192 : proj + (size_t)bb * SEQ * NPROJ + (HG ? C_BI : C_DV) + h * 128;
    const size_t old = DELTA ? 128 : NPROJ, ocs = DELTA ? 8192 : (size_t)64 * NPROJ;
    u32x2 ru[4][2];
#define K2_ULOAD(c_) do { if (DELTA && wave < 4) { _Pragma("unroll") for (int m = 0; m < 4; ++m) _Pragma("unroll") for (int nt = 0; nt < 2; ++nt) \
        ru[m][nt] = *(const u32x2*)(gUT + (size_t)(c_) * 8192 + (size_t)(dv0 + nt * 16 + fr) * 64 + m * 16 + fq * 4); } } while (0)
    K2_GLOAD(0); K2_LSTORE(); K2_ULOAD(0);
    __syncthreads();
    if (wave >= 4) {
        for (int c = 0; c < 64; ++c) {
            if (c + 1 < 64) K2_GLOAD(c + 1);
            __syncthreads();
            if (c + 1 < 64) K2_LSTORE();
            __syncthreads();
        }
    } else
    for (int c = 0; c < 64; ++c) {
        {
#pragma unroll
            for (int m = 0; m < MT; ++m)
#pragma unroll
                for (int nt = 0; nt < 2; ++nt) { u32x2 o; o.x = pk_bf16(accS[m][nt][0], accS[m][nt][1]); o.y = pk_bf16(accS[m][nt][2], accS[m][nt][3]);
                    *(LAS u32x2*)(pS + (nt * 16 + fr) * PD + m * 16 + fq * 4) = o; }
            asm volatile("s_waitcnt lgkmcnt(0)" ::: "memory");
#define K2_BS(ks_, nt_) (*(const LAS frag_t*)(pS + ((nt_) * 16 + fr) * PD + (ks_) * 32 + fq * 8))
#define K2_AF(base_, pd_, m_, ks_) (*(const LAS frag_t*)((base_) + ((m_) * 16 + fr) * (pd_) + (ks_) * 32 + fq * 8))
#define SB0 __builtin_amdgcn_sched_barrier(0)
            frag_t bX[2][2];
            frag_t fa[2][4], fb[2][2];
            if (DELTA) {
                f32x4 accV[4][2];
#pragma unroll
                for (int m = 0; m < 4; ++m)
#pragma unroll
                    for (int nt = 0; nt < 2; ++nt) { accV[m][nt][0] = -bf_lo(ru[m][nt].x); accV[m][nt][1] = -bf_hi(ru[m][nt].x); accV[m][nt][2] = -bf_lo(ru[m][nt].y); accV[m][nt][3] = -bf_hi(ru[m][nt].y); }
#pragma unroll
                for (int m = 0; m < 4; ++m) fa[0][m] = K2_AF(sA1, PD, m, 0);
                fb[0][0] = K2_BS(0, 0); fb[0][1] = K2_BS(0, 1);
#pragma unroll
                for (int ks = 0; ks < KS; ++ks) { const int cu = ks & 1, nx = cu ^ 1;
                    SB0;
                    if (ks + 1 < KS) {
#pragma unroll
                        for (int m = 0; m < 4; ++m) fa[nx][m] = K2_AF(sA1, PD, m, ks + 1);
                        fb[nx][0] = K2_BS(ks + 1, 0); fb[nx][1] = K2_BS(ks + 1, 1); }
#pragma unroll
                    for (int m = 0; m < 4; ++m) { accV[m][0] = MFMA16(fa[cu][m], fb[cu][0], accV[m][0]); accV[m][1] = MFMA16(fa[cu][m], fb[cu][1], accV[m][1]); } }
                SB0;
#pragma unroll
                for (int m = 0; m < 4; ++m)
#pragma unroll
                    for (int nt = 0; nt < 2; ++nt) { u32x2 o; o.x = pk_bf16(-accV[m][nt][0], -accV[m][nt][1]); o.y = pk_bf16(-accV[m][nt][2], -accV[m][nt][3]);
                        *(LAS u32x2*)(pX + (nt * 16 + fr) * P72 + m * 16 + fq * 4) = o; }
                asm volatile("s_waitcnt lgkmcnt(0)" ::: "memory");
#pragma unroll
                for (int ks = 0; ks < 2; ++ks)
#pragma unroll
                    for (int nt = 0; nt < 2; ++nt) bX[ks][nt] = *(const LAS frag_t*)(pX + (nt * 16 + fr) * P72 + ks * 32 + fq * 8);
            } else {
#pragma unroll
                for (int ks = 0; ks < 2; ++ks)
#pragma unroll
                    for (int nt = 0; nt < 2; ++nt) { const LAS bf16_t* vp = sA2 + (ks * 32 + fq * 8) * PD2 + dv0 + nt * 16 + fr;
                        frag_t f;
#pragma unroll
                        for (int j = 0; j < 8; ++j) f[j] = (short)vp[j * PD2];
                        bX[ks][nt] = f; }
            }
            SB0;
            {
                const LAS bf16_t* sQ = DELTA ? sA2 : sA1; constexpr int PQ = DELTA ? PD2 : PD;
                f32x4 ao[4][2];
#pragma unroll
                for (int m = 0; m < 4; ++m) { ao[m][0] = (f32x4){0.f, 0.f, 0.f, 0.f}; ao[m][1] = (f32x4){0.f, 0.f, 0.f, 0.f}; }
#pragma unroll
                for (int m = 0; m < 4; ++m) fa[0][m] = K2_AF(sQ, PQ, m, 0);
                fb[0][0] = K2_BS(0, 0); fb[0][1] = K2_BS(0, 1);
#pragma unroll
                for (int ks = 0; ks < KS + 2; ++ks) { const int cu = ks & 1, nx = cu ^ 1;
                    SB0;
                    if (ks + 1 < KS) {
#pragma unroll
                        for (int m = 0; m < 4; ++m) fa[nx][m] = K2_AF(sQ, PQ, m, ks + 1);
                        fb[nx][0] = K2_BS(ks + 1, 0); fb[nx][1] = K2_BS(ks + 1, 1); }
                    else if (ks + 1 < KS + 2) {
#pragma unroll
                        for (int m = 0; m < 4; ++m) fa[nx][m] = K2_AF(sAT, P72, m, ks + 1 - KS);
                        fb[nx][0] = bX[ks + 1 - KS][0]; fb[nx][1] = bX[ks + 1 - KS][1]; }
#pragma unroll
                    for (int m = 0; m < 4; ++m) { ao[m][0] = MFMA16(fa[cu][m], fb[cu][0], ao[m][0]); ao[m][1] = MFMA16(fa[cu][m], fb[cu][1], ao[m][1]); } }
                SB0;
#pragma unroll
                for (int m = 0; m < 4; ++m) { bf16_t* op = gO + (size_t)c * ocs + (size_t)(m * 16 + fq * 4) * old + dv0 + fr;
#pragma unroll
                    for (int r = 0; r < 4; ++r) { op[(size_t)r * old] = to_bf1(ao[m][0][r]); op[(size_t)r * old + 16] = to_bf1(ao[m][1][r]); } }
            }
            SB0;
            if (DELTA && c + 1 < 64) K2_ULOAD(c + 1);
            if (DELTA) { const float gl = sGD[0];
#pragma unroll
                for (int m = 0; m < MT; ++m) { accS[m][0] *= gl; accS[m][1] *= gl; } }
            else {
#pragma unroll
                for (int m = 0; m < MT; ++m) { const f32x4 gd = *(const LAS f32x4*)(sGD + m * 16 + fq * 4); accS[m][0] *= gd; accS[m][1] *= gd; } }
            {
                constexpr int NG = 2 * MT / 4;
#pragma unroll
                for (int q = 0; q < 4; ++q) fa[0][q] = K2_AF(sKT, P72, q % MT, q / MT);
#pragma unroll
                for (int g = 0; g < NG; ++g) { const int cu = g & 1, nx = cu ^ 1;
                    SB0;
                    if (g + 1 < NG) {
#pragma unroll
                        for (int q = 0; q < 4; ++q) { const int id = (g + 1) * 4 + q; fa[nx][q] = K2_AF(sKT, P72, id % MT, id / MT); } }
#pragma unroll
                    for (int q = 0; q < 4; ++q) { const int id = g * 4 + q, m = id % MT, ks = id / MT;
                        accS[m][0] = MFMA16(fa[cu][q], bX[ks][0], accS[m][0]); accS[m][1] = MFMA16(fa[cu][q], bX[ks][1], accS[m][1]); } }
                SB0;
            }
        }
        __syncthreads();
        __syncthreads();
    }
}
#undef K2_GLOAD
#undef K2_LSTORE
#undef K2_ULOAD
#undef K2_BS
#undef K2_AF
#undef SB0
__device__ __forceinline__ void lru_unit(LAS unsigned char* lds, unsigned char* aux, int bb, int cg) {
    const int tid = threadIdx.x, ch = tid & 15, seg = tid >> 4;
    LAS float* P = (LAS float*)lds; LAS float* Hs = P + 512;
    const size_t off = ((size_t)bb * SEQ + (size_t)seg * 128) * 512 + cg * 16 + ch;
    const bf16_t* om = (const bf16_t*)(aux + AX_LOM) + off; bf16_t* lb = (bf16_t*)(aux + AX_LB) + off;
    float p = 1.f, hv = 0.f;
#pragma unroll 8
    for (int t = 0; t < 128; ++t) { const float a = 1.f - bf1(om[(size_t)t * 512]), b = bf1(lb[(size_t)t * 512]); hv = fmaf(a, hv, b); p *= a; }
    P[tid] = p; Hs[tid] = hv;
    __syncthreads();
    float carry = 0.f;
    for (int s = 0; s < seg; ++s) carry = fmaf(P[s * 16 + ch], carry, Hs[s * 16 + ch]);
    hv = carry;
#pragma unroll 8
    for (int t = 0; t < 128; ++t) { const float a = 1.f - bf1(om[(size_t)t * 512]), b = bf1(lb[(size_t)t * 512]); hv = fmaf(a, hv, b); lb[(size_t)t * 512] = to_bf1(hv); }
    __syncthreads();
}
__device__ __forceinline__ void b2_scan(const Args& A, LAS unsigned char* lds) {
    bf16_t* proj = (bf16_t*)(A.ws + WS_PROJ); unsigned char* aux = A.ws + WS_AUX;
    const int u = blockIdx.x;
    if (u < 16) k2_unit<true, 128>(lds, aux, proj, u);
    else if (u < 32) k2_unit<false, 128>(lds, aux, proj, u - 16);
    else if (u < 48) k2_unit<false, 64>(lds, aux, proj, u - 32);
    else if (u < 176) { const int r = u - 48; lru_unit(lds, aux, r >> 5, r & 31); }
}

__device__ __forceinline__ void b3_post(const Args& A, int l) {
    const int tid = threadIdx.x, lane = tid & 63, wave = __builtin_amdgcn_readfirstlane(tid >> 6), G = gridDim.x;
    bf16_t* proj = (bf16_t*)(A.ws + WS_PROJ); unsigned char* aux = A.ws + WS_AUX;
    const int cin = (lane & 15) * 8;
    float wn[3][8];
    { const float* p0 = A.in[I_GNORM] + l * 128 + cin; const float* p1 = A.in[I_HNORM] + l * 128 + cin; const float* p2 = A.in[I_DNORM] + l * 128 + cin;
#pragma unroll
        for (int j = 0; j < 8; ++j) { wn[0][j] = p0[j]; wn[1][j] = p1[j]; wn[2][j] = p2[j]; } }
    for (int row = blockIdx.x * NWAVES + wave; row < HM; row += G * NWAVES) {
        bf16_t* pr = proj + (size_t)row * NPROJ;
        float o[8], g[8], y[8];
        { const int bb = row >> 12, t = row & 4095, hh = lane >> 4; const size_t ci = (size_t)(bb * 4 + hh) * 64 + (t >> 6);
            load8((const bf16_t*)(aux + AX_GO) + (ci * 64 + (t & 63)) * 128 + cin, o); }
        load8(pr + C_AZ + lane * 8, g);
        { float ss = 0.f;
#pragma unroll
            for (int j = 0; j < 8; ++j) { o[j] *= 0.08838834764831845f; ss += o[j] * o[j]; }
            ss = row_sum16(ss); const float r = rsqrtf(ss * (1.f / 128.f) + EPS);
#pragma unroll
            for (int j = 0; j < 8; ++j) y[j] = o[j] * r * wn[0][j] * siluf_(g[j]);
            *(u32x4*)(pr + C_AZ + lane * 8) = pack8(y); }
        load8(pr + C_BI + lane * 8, o); load8(pr + C_BG + lane * 8, g);
        { float ss = 0.f;
#pragma unroll
            for (int j = 0; j < 8; ++j) { o[j] *= 0.08838834764831845f; ss += o[j] * o[j]; }
            ss = row_sum16(ss); const float r = rsqrtf(ss * (1.f / 128.f) + EPS);
#pragma unroll
            for (int j = 0; j < 8; ++j) y[j] = o[j] * r * wn[1][j] * siluf_(g[j]);
            *(u32x4*)(pr + C_BG + lane * 8) = pack8(y); }
        load8((const bf16_t*)(aux + AX_LB) + (size_t)row * 512 + lane * 8, o); load8(pr + C_CG + lane * 8, g);
#pragma unroll
        for (int j = 0; j < 8; ++j) y[j] = o[j] * gelu_tanh(g[j]);
        *(u32x4*)(pr + C_CG + lane * 8) = pack8(y);
        load8(pr + C_DV + lane * 8, o); load8(pr + C_DG + lane * 8, g);
        { float ss = 0.f;
#pragma unroll
            for (int j = 0; j < 8; ++j) { o[j] *= 0.125f; ss += o[j] * o[j]; }
            ss = row_sum16(ss); const float r = rsqrtf(ss * (1.f / 128.f) + EPS);
#pragma unroll
            for (int j = 0; j < 8; ++j) y[j] = o[j] * r * wn[2][j] * siluf_(g[j]);
            *(u32x4*)(pr + C_DG + lane * 8) = pack8(y); }
    }
}

__device__ const unsigned char PAIR_IJ[56] = {
    0x00, 0x01, 0x02, 0x03, 0x04, 0x05, 0x06, 0x07, 0x08, 0x09, 0x0A, 0x0B, 0x0C, 0x0D, 0x0E, 0x0F,
    0x10, 0x11, 0x12, 0x13, 0x14, 0x15, 0x16, 0x17, 0x20, 0x21, 0x22, 0x23, 0x24, 0x30, 0x31, 0x32, 0x33,
    0x40, 0x41, 0x42, 0x50, 0x51, 0x60, 0x61, 0x70, 0x71, 0x80, 0x90, 0xA0, 0xB0, 0xC0, 0xD0, 0xE0, 0xF0,
    0xFF, 0xFF, 0xFF, 0xFF, 0xFF, 0xFF };
__device__ __forceinline__ float fmax_dpp_quad(float m) { m = fmaxf(m, dpp_f<0xB1>(m)); m = fmaxf(m, dpp_f<0x4E>(m)); return m; }
typedef float f32x2 __attribute__((ext_vector_type(2)));
__device__ __forceinline__ float dot16_fp4(const u32x2 u, const float (&h)[16], float p) {
    const unsigned w0 = u.x, w1 = u.y;
    f32x2 a;
    a = __builtin_amdgcn_cvt_scalef32_pk_f32_fp4(w0, 1.0f, 0); p = fmaf(h[0], a.x, p); p = fmaf(h[1], a.y, p);
    a = __builtin_amdgcn_cvt_scalef32_pk_f32_fp4(w0, 1.0f, 1); p = fmaf(h[2], a.x, p); p = fmaf(h[3], a.y, p);
    a = __builtin_amdgcn_cvt_scalef32_pk_f32_fp4(w0, 1.0f, 2); p = fmaf(h[4], a.x, p); p = fmaf(h[5], a.y, p);
    a = __builtin_amdgcn_cvt_scalef32_pk_f32_fp4(w0, 1.0f, 3); p = fmaf(h[6], a.x, p); p = fmaf(h[7], a.y, p);
    a = __builtin_amdgcn_cvt_scalef32_pk_f32_fp4(w1, 1.0f, 0); p = fmaf(h[8], a.x, p); p = fmaf(h[9], a.y, p);
    a = __builtin_amdgcn_cvt_scalef32_pk_f32_fp4(w1, 1.0f, 1); p = fmaf(h[10], a.x, p); p = fmaf(h[11], a.y, p);
    a = __builtin_amdgcn_cvt_scalef32_pk_f32_fp4(w1, 1.0f, 2); p = fmaf(h[12], a.x, p); p = fmaf(h[13], a.y, p);
    a = __builtin_amdgcn_cvt_scalef32_pk_f32_fp4(w1, 1.0f, 3); p = fmaf(h[14], a.x, p); p = fmaf(h[15], a.y, p);
    return p;
}
__device__ __forceinline__ void axpy16_fp4(const u32x2 v, float c, float (&acc)[16]) {
    const unsigned w0 = v.x, w1 = v.y;
    f32x2 a;
    a = __builtin_amdgcn_cvt_scalef32_pk_f32_fp4(w0, 1.0f, 0); acc[0] = fmaf(c, a.x, acc[0]); acc[1] = fmaf(c, a.y, acc[1]);
    a = __builtin_amdgcn_cvt_scalef32_pk_f32_fp4(w0, 1.0f, 1); acc[2] = fmaf(c, a.x, acc[2]); acc[3] = fmaf(c, a.y, acc[3]);
    a = __builtin_amdgcn_cvt_scalef32_pk_f32_fp4(w0, 1.0f, 2); acc[4] = fmaf(c, a.x, acc[4]); acc[5] = fmaf(c, a.y, acc[5]);
    a = __builtin_amdgcn_cvt_scalef32_pk_f32_fp4(w0, 1.0f, 3); acc[6] = fmaf(c, a.x, acc[6]); acc[7] = fmaf(c, a.y, acc[7]);
    a = __builtin_amdgcn_cvt_scalef32_pk_f32_fp4(w1, 1.0f, 0); acc[8] = fmaf(c, a.x, acc[8]); acc[9] = fmaf(c, a.y, acc[9]);
    a = __builtin_amdgcn_cvt_scalef32_pk_f32_fp4(w1, 1.0f, 1); acc[10] = fmaf(c, a.x, acc[10]); acc[11] = fmaf(c, a.y, acc[11]);
    a = __builtin_amdgcn_cvt_scalef32_pk_f32_fp4(w1, 1.0f, 2); acc[12] = fmaf(c, a.x, acc[12]); acc[13] = fmaf(c, a.y, acc[13]);
    a = __builtin_amdgcn_cvt_scalef32_pk_f32_fp4(w1, 1.0f, 3); acc[14] = fmaf(c, a.x, acc[14]); acc[15] = fmaf(c, a.y, acc[15]);
}
constexpr int PE_LDS_WAVE = 4096;
__device__ __forceinline__ void pe_peer(const Args& A, LAS unsigned char* lds, int l, bool last) {
    const int tid = threadIdx.x, lane = tid & 63, wave = __builtin_amdgcn_readfirstlane(tid >> 6), G = gridDim.x;
    const float NEG_INF = __uint_as_float(0xFF800000u);
    LAS unsigned* tl = (LAS unsigned*)(lds + wave * PE_LDS_WAVE);
    LAS unsigned* el = tl + 256;
    LAS float* gl = (LAS float*)(el + 128);
    LAS float* sul = gl + 128;
    LAS float* svl = sul + 128;
    float* X = A.out; bf16_t* XB = (bf16_t*)(A.ws + WS_XB); float* rstd1 = (float*)(A.ws + WS_RSTD1);
    const float* SC = (const float*)(A.ws + WS_SCORES);
    const unsigned char* U = A.ws + WS_U8; const unsigned char* V = A.ws + WS_V8;
    const float* SU = (const float*)(A.ws + WS_SU); const float* SV = (const float*)(A.ws + WS_SV);
    const float* nf = A.in[I_NFFN] + l * DM; const float* nfin = A.in[I_NFIN];
    for (int n = blockIdx.x * NWAVES + wave; n < MTOK; n += G * NWAVES) {
        float h[16]; float rstd2;
        { const float* xr = X + (size_t)n * DM + 16 * lane; const float* wr = nf + 16 * lane;
            float ss = 0.f;
#pragma unroll
            for (int j = 0; j < 4; ++j) { const f32x4 a = *(const f32x4*)(xr + 4 * j); h[4 * j] = a[0]; h[4 * j + 1] = a[1]; h[4 * j + 2] = a[2]; h[4 * j + 3] = a[3];
                ss += (a[0] * a[0] + a[1] * a[1]) + (a[2] * a[2] + a[3] * a[3]); }
            ss = wave_sum64(ss); rstd2 = rsqrtf(ss * (1.f / DM) + EPS);
#pragma unroll
            for (int j = 0; j < 4; ++j) { const f32x4 w = *(const f32x4*)(wr + 4 * j); h[4 * j] *= rstd2 * w[0]; h[4 * j + 1] *= rstd2 * w[1]; h[4 * j + 2] *= rstd2 * w[2]; h[4 * j + 3] *= rstd2 * w[3]; } }
        {
            const int sub = lane & 3, gidx = lane >> 2;
            const float* sp = SC + (size_t)n * 2048 + gidx * 128 + sub * 32;
            float val[32];
#pragma unroll
            for (int q = 0; q < 8; ++q) { const f32x4 s = *(const f32x4*)(sp + q * 4);
#pragma unroll
                for (int j = 0; j < 4; ++j) val[q * 4 + j] = __uint_as_float((__float_as_uint(s[j]) & ~0x7Fu) | (unsigned)(sub * 32 + q * 4 + j)); }
            float top[16];
#pragma unroll
            for (int it = 0; it < 16; ++it) {
                float m = val[0];
#pragma unroll
                for (int i = 1; i < 32; ++i) m = fmaxf(m, val[i]);
                m = fmax_dpp_quad(m);
                top[it] = m;
#pragma unroll
                for (int i = 0; i < 32; ++i) val[i] = (__float_as_uint(val[i]) == __float_as_uint(m)) ? NEG_INF : val[i];
            }
            if (sub == 0) {
#pragma unroll
                for (int it = 0; it < 16; ++it) tl[gidx * 16 + it] = __float_as_uint(top[it]); }
        }
        __builtin_amdgcn_wave_barrier(); asm volatile("s_waitcnt lgkmcnt(0)" ::: "memory");
        {
            const int hh = lane >> 3, slot = lane & 7;
            float cand[7];
#pragma unroll
            for (int q = 0; q < 7; ++q) { const unsigned code = PAIR_IJ[slot + 8 * q];
                if (code != 0xFFu) { const float a = __uint_as_float(tl[(2 * hh) * 16 + (code >> 4)] & ~0x7Fu), b = __uint_as_float(tl[(2 * hh + 1) * 16 + (code & 15u)] & ~0x7Fu);
                    cand[q] = __uint_as_float((__float_as_uint(a + b) & ~0xFFu) | code); }
                else cand[q] = NEG_INF; }
            float best[16];
#pragma unroll
            for (int it = 0; it < 16; ++it) {
                float m = cand[0];
#pragma unroll
                for (int q = 1; q < 7; ++q) m = fmaxf(m, cand[q]);
                m = fmax_dpp_quad(m); m = fmaxf(m, dpp_f<0x141>(m));
                best[it] = m;
#pragma unroll
                for (int q = 0; q < 7; ++q) cand[q] = (__float_as_uint(cand[q]) == __float_as_uint(m)) ? NEG_INF : cand[q];
            }
            const float b0 = __uint_as_float(__float_as_uint(best[0]) & ~0xFFu);
            float e[16], es = 0.f;
#pragma unroll
            for (int k = 0; k < 16; ++k) { e[k] = __expf((__uint_as_float(__float_as_uint(best[k]) & ~0xFFu) - b0) * rstd2); es += e[k]; }
            const float inv = 1.f / es;
#pragma unroll
            for (int k = 0; k < 16; ++k) if ((k & 7) == slot) { const unsigned code = __float_as_uint(best[k]) & 0xFFu;
                const unsigned i0 = tl[(2 * hh) * 16 + (code >> 4)] & 0x7Fu, i1 = tl[(2 * hh + 1) * 16 + (code & 15u)] & 0x7Fu, ex = i0 * 128u + i1;
                el[hh * 16 + k] = ex; gl[hh * 16 + k] = e[k] * inv; sul[hh * 16 + k] = SU[ex]; svl[hh * 16 + k] = SV[ex]; }
        }
        __builtin_amdgcn_wave_barrier(); asm volatile("s_waitcnt lgkmcnt(0)" ::: "memory");
        float acc[16];
#pragma unroll
        for (int i = 0; i < 16; ++i) acc[i] = 0.f;
#define PE_LOAD(ub_, vb_, b_) do { _Pragma("unroll") for (int r = 0; r < 8; ++r) { const unsigned e_ = (unsigned)__builtin_amdgcn_readfirstlane((int)el[(b_) * 8 + r]); \
            ub_[r] = *(const u32x2*)(U + (size_t)e_ * (DM / 2) + 8 * lane); vb_[r] = *(const u32x2*)(V + (size_t)e_ * (DM / 2) + 8 * lane); } } while (0)
#define PE_COMP(ub_, vb_, b_) do { float p_[8]; \
            _Pragma("unroll") for (int r = 0; r < 8; ++r) p_[r] = dot16_fp4(ub_[r], h, 0.f); \
              \
            float q_[4]; \
            _Pragma("unroll") for (int i = 0; i < 4; ++i) { const float keep = (lane & 1) ? p_[2 * i + 1] : p_[2 * i], send = (lane & 1) ? p_[2 * i] : p_[2 * i + 1]; q_[i] = keep + __shfl_xor(send, 1); } \
            float s_[2]; \
            _Pragma("unroll") for (int i = 0; i < 2; ++i) { const float keep = (lane & 2) ? q_[2 * i + 1] : q_[2 * i], send = (lane & 2) ? q_[2 * i] : q_[2 * i + 1]; s_[i] = keep + __shfl_xor(send, 2); } \
            float t_; { const float keep = (lane & 4) ? s_[1] : s_[0], send = (lane & 4) ? s_[0] : s_[1]; t_ = keep + __shfl_xor(send, 4); } \
            t_ += __shfl_xor(t_, 8); t_ += __shfl_xor(t_, 16); t_ += __shfl_xor(t_, 32); \
            const int ri_ = (b_) * 8 + (lane & 7); \
            const float cl_ = gl[ri_] * gelu_tanh(t_ * sul[ri_]) * svl[ri_]; \
            _Pragma("unroll") for (int r = 0; r < 8; ++r) { const float c = rdlane(cl_, r); axpy16_fp4(vb_[r], c, acc); } } while (0)
        {
            u32x2 uA[8], vA[8], uB[8], vB[8];
            PE_LOAD(uA, vA, 0);
#pragma unroll 1
            for (int b = 0; b < 16; b += 2) {
                PE_LOAD(uB, vB, b + 1);
                PE_COMP(uA, vA, b);
                if (b + 2 < 16) PE_LOAD(uA, vA, b + 2);
                PE_COMP(uB, vB, b + 1);
            }
        }
#undef PE_LOAD
#undef PE_COMP
        { float* xr = X + (size_t)n * DM + 16 * lane;
            f32x4 a[4]; float ss = 0.f;
#pragma unroll
            for (int j = 0; j < 4; ++j) { a[j] = *(const f32x4*)(xr + 4 * j); a[j][0] += acc[4 * j]; a[j][1] += acc[4 * j + 1]; a[j][2] += acc[4 * j + 2]; a[j][3] += acc[4 * j + 3];
                ss += (a[j][0] * a[j][0] + a[j][1] * a[j][1]) + (a[j][2] * a[j][2] + a[j][3] * a[j][3]); }
            ss = wave_sum64(ss); const float rs = rsqrtf(ss * (1.f / DM) + EPS);
            if (!last) {
#pragma unroll
                for (int j = 0; j < 4; ++j) *(f32x4*)(xr + 4 * j) = a[j];
                bf16_t* bp = XB + (size_t)n * DM + 16 * lane;
                u32x4 o; o.x = pk_bf16(a[0][0], a[0][1]); o.y = pk_bf16(a[0][2], a[0][3]); o.z = pk_bf16(a[1][0], a[1][1]); o.w = pk_bf16(a[1][2], a[1][3]); *(u32x4*)bp = o;
                o.x = pk_bf16(a[2][0], a[2][1]); o.y = pk_bf16(a[2][2], a[2][3]); o.z = pk_bf16(a[3][0], a[3][1]); o.w = pk_bf16(a[3][2], a[3][3]); *(u32x4*)(bp + 8) = o;
                if (lane == 0) rstd1[n] = rs;
            } else {
#pragma unroll
                for (int j = 0; j < 4; ++j) { const f32x4 w = *(const f32x4*)(nfin + 16 * lane + 4 * j); *(f32x4*)(xr + 4 * j) = a[j] * rs * w; }
            }
        }
        __builtin_amdgcn_wave_barrier(); asm volatile("s_waitcnt lgkmcnt(0)" ::: "memory");
    }
}

__global__ void __launch_bounds__(NTHREADS, 2) fwd_kernel(Args A) {
    extern __shared__ __attribute__((aligned(16))) unsigned char smem[];
    LAS unsigned char* lds = (LAS unsigned char*)smem;
    const int tid = threadIdx.x, G = gridDim.x;
    const int lo = A.lo, hi = A.hi;
#define IN(k) (lo <= (k) && (k) < hi)
#define BOTH(k) (IN(k) && IN((k) + 1))
    volatile LAS unsigned* misc = (volatile LAS unsigned*)(lds + LDS_MISC);
    if (tid < 16) misc[tid] = 0u;
    __syncthreads();
    XcdBarrier bar; bar.bar = (unsigned*)(A.ws + WS_BAR); bar.x = 0; bar.st = misc;
    if (hi - lo > 1) bar = xcd_barrier_post((unsigned*)(A.ws + WS_BAR), misc);
#define SEAM(k) do { if (BOTH(k)) xcd_barrier(bar); } while (0)

#ifndef PHM
#define PHM 0xFF
#endif
    if (IN(0)) { if (PHM & 1) p0_prologue(A, lds); SEAM(0); }
#define RUN_HALF(l, half) do { \
        const int ph = 1 + (l) * 12 + (half) * 5; \
        if (IN(ph + 0)) { \
            pg8::Gemm g{(const bf16_t*)(A.ws + WS_XB) + (size_t)(half) * HM * DM, (const bf16_t*)(A.ws + WS_WIN) + (size_t)(l) * NPROJP * DM, HM, NPROJP, DM, DM}; \
            pg8::StaticOrder S; S.init(HM, NPROJP, G, (int)blockIdx.x); \
            pg8::EpiProj E{(bf16_t*)(A.ws + WS_PROJ), (const float*)(A.ws + WS_RSTD1) + (half) * HM}; \
            if (PHM & 2) pg8::gemm_phase<pg8::EpiProj>(lds, g, S, E); \
            SEAM(ph + 0); \
        } \
        if (IN(ph + 1)) { if (PHM & 4) b1_prep(A, lds, (l), (half)); SEAM(ph + 1); } \
        if (IN(ph + 2)) { if (PHM & 8) b2_scan(A, lds); SEAM(ph + 2); } \
        if (IN(ph + 3)) { if (PHM & 16) b3_post(A, (l)); SEAM(ph + 3); } \
        if (IN(ph + 4)) { \
            pg8::Gemm g{(const bf16_t*)(A.ws + WS_PROJ) + C_Y, (const bf16_t*)(A.ws + WS_WOUT) + (size_t)(l) * DM * 2048, HM, DM, 2048, NPROJ}; \
            pg8::StaticOrder S; S.init(HM, DM, G, (int)blockIdx.x); \
            pg8::EpiResid E{A.out + (size_t)(half) * HM * DM, (bf16_t*)(A.ws + WS_XB) + (size_t)(half) * HM * DM}; \
            if (PHM & 32) pg8::gemm_phase<pg8::EpiResid>(lds, g, S, E); \
            SEAM(ph + 4); \
        } } while (0)
#define RUN_TAIL(l) do { \
        const int pb = 1 + (l) * 12; \
        if (IN(pb + 10)) { \
            pg8::Gemm g{(const bf16_t*)(A.ws + WS_XB), (const bf16_t*)(A.ws + WS_WEFF) + (size_t)(l) * 2048 * DM, MTOK, 2048, DM, DM}; \
            pg8::StaticOrder S; S.init(MTOK, 2048, G, (int)blockIdx.x); \
            pg8::EpiF32 E{(float*)(A.ws + WS_SCORES), 2048}; \
            convert_tables(A, (l)); \
            if (PHM & 64) pg8::gemm_phase<pg8::EpiF32>(lds, g, S, E); \
            SEAM(pb + 10); \
        } \
        if (IN(pb + 11)) { if (PHM & 128) pe_peer(A, lds, (l), (l) == NLAYER - 1); SEAM(pb + 11); } } while (0)
    RUN_HALF(0, 0); RUN_HALF(0, 1); RUN_TAIL(0);
    RUN_HALF(1, 0); RUN_HALF(1, 1); RUN_TAIL(1);
#undef RUN_HALF
#undef RUN_TAIL
#undef IN
#undef BOTH
#undef SEAM
}
constexpr int NPHASES = 1 + NLAYER * 12;

extern "C" void kernel_launch(void* const* d_in, const int* in_sizes, int n_in, void* d_out, int out_size, void* d_ws, size_t ws_size, hipStream_t stream) {
    static int grid = 0;
    if (grid == 0) {
        if (n_in != 26 || out_size != MTOK * DM || ws_size < WS_END) { fprintf(stderr, "kernel_launch: unexpected shapes (n_in %d out %d ws %zu need %zu)\n", n_in, out_size, ws_size, (size_t)WS_END); grid = -1; return; }
        int dev = 0, cus = 0;
        if (hipGetDevice(&dev) != hipSuccess || hipDeviceGetAttribute(&cus, hipDeviceAttributeMultiprocessorCount, dev) != hipSuccess) { grid = -1; return; }
        if (hipFuncSetAttribute((const void*)fwd_kernel, hipFuncAttributeMaxDynamicSharedMemorySize, LDS_BYTES) != hipSuccess) { fprintf(stderr, "kernel_launch: hipFuncSetAttribute failed\n"); grid = -1; return; }
        int per_cu = 0;
        if (hipOccupancyMaxActiveBlocksPerMultiprocessor(&per_cu, (const void*)fwd_kernel, NTHREADS, LDS_BYTES) != hipSuccess || per_cu < 1) { fprintf(stderr, "kernel_launch: occupancy query says %d\n", per_cu); (void)hipGetLastError(); }
        grid = cus;
    }
    if (grid < 0) return;
    (void)hipMemsetAsync((char*)d_ws + WS_BAR, 0, 16384, stream);
    Args a{};
    for (int i = 0; i < 26; ++i) a.in[i] = (const float*)d_in[i];
    a.out = (float*)d_out; a.ws = (unsigned char*)d_ws;
#if MK_N_LAUNCHES == 1
    a.lo = 0; a.hi = NPHASES;
    hipLaunchKernelGGL(fwd_kernel, dim3(grid), dim3(NTHREADS), LDS_BYTES, stream, a);
#else
    for (int p = 0; p < NPHASES; ++p) { a.lo = p; a.hi = p + 1; hipLaunchKernelGGL(fwd_kernel, dim3(grid), dim3(NTHREADS), LDS_BYTES, stream, a); }
#endif
}
```

```cpp
#include <hip/hip_runtime.h>
#include <stdint.h>
#include <cstdio>

#ifndef MK_N_LAUNCHES
#define MK_N_LAUNCHES 1
#endif

#define LAS __attribute__((address_space(3)))
typedef unsigned short bf16_t;
typedef short bf16x8 __attribute__((ext_vector_type(8)));
typedef float f32x4 __attribute__((ext_vector_type(4)));
typedef unsigned u32x4 __attribute__((ext_vector_type(4)));
typedef unsigned u32x2 __attribute__((ext_vector_type(2)));
typedef __bf16 bf16v2 __attribute__((ext_vector_type(2)));

constexpr int DM = 1024, SEQ = 4096, NBATCH = 8, MTOK = NBATCH * SEQ, HM = MTOK / 2, NLAYER = 2;
constexpr int NPROJ = 6680, NPROJP = 6912;
constexpr float EPS = 1e-6f;
constexpr int C_AQ = 0, C_AK = 512, C_AV = 1024, C_BQ = 1536, C_BF = 2048, C_BI = 2560, C_CX = 3072, C_DQ = 3584, C_DK = 3840, C_DV = 4096,
              C_AZ = 4608, C_BG = 5120, C_CG = 5632, C_DG = 6144, C_AA = 6656, C_AB = 6660, C_DLR = 6664, C_Y = 4608;
constexpr int NCI = 1024;
constexpr size_t AX_GW = 0,
                 AX_GQ = AX_GW + (size_t)NCI * 64 * 128 * 2,
                 AX_GUT = AX_GQ + (size_t)NCI * 64 * 128 * 2,
                 AX_GKT = AX_GUT + (size_t)NCI * 64 * 128 * 2,
                 AX_GO = AX_GKT + (size_t)NCI * 64 * 128 * 2,
                 AX_GQK = AX_GO + (size_t)NCI * 64 * 128 * 2,
                 AX_GGL = AX_GQK + (size_t)NCI * 64 * 64 * 2,
                 AX_HATT = AX_GGL + (size_t)NCI * 4,
                 AX_HKT = AX_HATT + (size_t)NCI * 64 * 64 * 2,
                 AX_HGD = AX_HKT + (size_t)NCI * 128 * 64 * 2,
                 AX_DATT = AX_HGD + (size_t)NCI * 128 * 4,
                 AX_DKT = AX_DATT + (size_t)NCI * 64 * 64 * 2,
                 AX_DGD = AX_DKT + (size_t)NCI * 64 * 64 * 2,
                 AX_LOM = AX_DGD + (size_t)NCI * 64 * 4,
                 AX_LB = AX_LOM + (size_t)HM * 512 * 2,
                 AX_END = AX_LB + (size_t)HM * 512 * 2;
constexpr size_t WS_BAR = 0, WS_RSTD1 = 16384, WS_WIN = WS_RSTD1 + (size_t)MTOK * 4, WS_WOUT = WS_WIN + (size_t)NLAYER * NPROJP * DM * 2,
                 WS_WEFF = WS_WOUT + (size_t)NLAYER * DM * 2048 * 2, WS_LRUW = WS_WEFF + (size_t)NLAYER * 2048 * DM * 2,
                 WS_SU = WS_LRUW + (size_t)NLAYER * 2 * 4 * 128 * 128 * 2, WS_SV = WS_SU + (size_t)16384 * 4, WS_XB = WS_SV + (size_t)16384 * 4,
                 WS_PROJ = WS_XB + (size_t)MTOK * DM * 2, WS_AUX = WS_PROJ + (size_t)HM * NPROJ * 2, WS_END = WS_AUX + AX_END,
                 WS_SCORES = WS_PROJ,
                 WS_U8 = WS_SCORES + (size_t)MTOK * 2048 * 4,
                 WS_V8 = WS_U8 + (size_t)16384 * DM / 2;
static_assert(WS_V8 + (size_t)16384 * DM / 2 <= WS_END, "scores + expert tables alias");
static_assert(WS_PROJ % 256 == 0 && WS_AUX % 16 == 0 && WS_WIN % 256 == 0 && AX_GGL % 16 == 0 && AX_HATT % 16 == 0 && AX_LOM % 16 == 0, "alignment");

#define XB_TMO      128
#define XB_XCNT(j)  (256  + 64 * (j))
#define XB_XSUB(j)  (1280 + 64 * (j))
#define XB_XGEN(j)  (2304 + 64 * (j))
#define XB_TOP      3328
#define XB_TOPGEN   3392
#define XCD_BAR_WORDS 3456
#define XB_SPIN_CAP (1u << 24)
__device__ __forceinline__ unsigned xb_ld(unsigned* p)              { return __hip_atomic_load(p, __ATOMIC_RELAXED, __HIP_MEMORY_SCOPE_AGENT); }
__device__ __forceinline__ unsigned xb_add(unsigned* p, unsigned v) { return __hip_atomic_fetch_add(p, v, __ATOMIC_RELAXED, __HIP_MEMORY_SCOPE_AGENT); }
__device__ __forceinline__ unsigned xb_xcc_id() { return (unsigned)__builtin_amdgcn_s_getreg((3 << 11) | 20) & 0xFu; }
#define XB_SPIN(cond, bar) do { unsigned _sp = 0; while (cond) { __builtin_amdgcn_s_sleep(1); \
    if ((++_sp & 255u) == 0u) { if (xb_ld(&(bar)[XB_TMO])) break; if (_sp > XB_SPIN_CAP) { atomicAdd(&(bar)[XB_TMO], 1u); break; } } } } while (0)
struct XcdBarrier { unsigned* bar; unsigned x; volatile LAS unsigned* st; };
__device__ __forceinline__ XcdBarrier xcd_barrier_post(unsigned* bar, volatile LAS unsigned* st) {
    XcdBarrier b; b.bar = bar; b.x = xb_xcc_id(); b.st = st;
    if (threadIdx.x == 0) (void)xb_add(&bar[XB_XCNT(b.x)], 1u);
    return b;
}
__device__ __forceinline__ void xcd_barrier_complete(unsigned* bar, unsigned x, unsigned& nloc, unsigned& nx) {
    const unsigned G = gridDim.x * gridDim.y * gridDim.z;
    unsigned sum, cnt, mine, sp = 0u;
    for (;;) {
        sum = 0u; cnt = 0u; mine = 0u;
#pragma unroll
        for (unsigned j = 0; j < 16; ++j) { const unsigned c = xb_ld(&bar[XB_XCNT(j)]); sum += c; cnt += (c > 0u) ? 1u : 0u; mine = (j == x) ? c : mine; }
        if (sum == G) break;
        __builtin_amdgcn_s_sleep(1);
        if ((++sp & 255u) == 0u) { if (xb_ld(&bar[XB_TMO])) break; if (sp > XB_SPIN_CAP) { atomicAdd(&bar[XB_TMO], 1u); break; } }
    }
    nloc = mine > 0u ? mine : 1u; nx = cnt > 0u ? cnt : 1u;
}
__device__ __forceinline__ void xcd_barrier(const XcdBarrier& b) {
    asm volatile("s_waitcnt vmcnt(0)" ::: "memory");
    __syncthreads();
    if (threadIdx.x == 0) {
        unsigned* bar = b.bar;
        __builtin_amdgcn_s_waitcnt(0);
        unsigned nloc = b.st[0], nx = b.st[1];
        if (nloc == 0u) { xcd_barrier_complete(bar, b.x, nloc, nx); b.st[0] = nloc; b.st[1] = nx; }
        const unsigned old = xb_add(&bar[XB_XSUB(b.x)], 1u);
        const unsigned gen = old / nloc;
        if (old + 1u == (gen + 1u) * nloc) {
            __builtin_amdgcn_fence(__ATOMIC_RELEASE, "agent");
            asm volatile("s_waitcnt vmcnt(0)" ::: "memory");
            const unsigned og = xb_add(&bar[XB_TOP], 1u);
            const unsigned tg = og / nx;
            if (og + 1u == (tg + 1u) * nx) xb_add(&bar[XB_TOPGEN], 1u);
            else XB_SPIN(xb_ld(&bar[XB_TOPGEN]) == tg, bar);
            __builtin_amdgcn_fence(__ATOMIC_ACQUIRE, "agent");
            xb_add(&bar[XB_XGEN(b.x)], 1u);
            asm volatile("s_waitcnt vmcnt(0)" ::: "memory");
        } else {
            XB_SPIN(xb_ld(&bar[XB_XGEN(b.x)]) == gen, bar);
            __builtin_amdgcn_fence(__ATOMIC_ACQUIRE, "agent");
            asm volatile("s_waitcnt vmcnt(0)" ::: "memory");
        }
    }
    __syncthreads();
}

__device__ __forceinline__ float bf_lo(unsigned u) { return __uint_as_float(u << 16); }
__device__ __forceinline__ float bf_hi(unsigned u) { return __uint_as_float(u & 0xffff0000u); }
__device__ __forceinline__ float bf1(bf16_t h) { return __uint_as_float(((unsigned)h) << 16); }
__device__ __forceinline__ unsigned pk_bf16(float lo, float hi) { bf16v2 v; v.x = (__bf16)lo; v.y = (__bf16)hi; return __builtin_bit_cast(unsigned, v); }
__device__ __forceinline__ bf16_t to_bf1(float f) { return (bf16_t)(pk_bf16(f, 0.f) & 0xffffu); }
__device__ __forceinline__ void unpack8(const u32x4 v, float (&f)[8]) {
    f[0] = bf_lo(v.x); f[1] = bf_hi(v.x); f[2] = bf_lo(v.y); f[3] = bf_hi(v.y); f[4] = bf_lo(v.z); f[5] = bf_hi(v.z); f[6] = bf_lo(v.w); f[7] = bf_hi(v.w);
}
__device__ __forceinline__ u32x4 pack8(const float (&f)[8]) { u32x4 o; o.x = pk_bf16(f[0], f[1]); o.y = pk_bf16(f[2], f[3]); o.z = pk_bf16(f[4], f[5]); o.w = pk_bf16(f[6], f[7]); return o; }
__device__ __forceinline__ float fast_rcp(float x) { return __builtin_amdgcn_rcpf(x); }
__device__ __forceinline__ float sigmoidf_(float x) { return fast_rcp(1.f + __expf(-x)); }
__device__ __forceinline__ float siluf_(float x) { return x * sigmoidf_(x); }
__device__ __forceinline__ float softplusf_(float x) { return fmaxf(x, 0.f) + log1pf(__expf(-fabsf(x))); }
__device__ __forceinline__ float gelu_tanh(float x) {
    const float u = 0.7978845608028654f * (x + 0.044715f * x * x * x);
    const float t = 1.f - 2.f * fast_rcp(__expf(2.f * u) + 1.f);
    return 0.5f * x * (1.f + t);
}
template <int CTRL> __device__ __forceinline__ float dpp_f(float v) { return __int_as_float(__builtin_amdgcn_update_dpp(0, __float_as_int(v), CTRL, 0xf, 0xf, true)); }
__device__ __forceinline__ float row_sum16(float v) { v += dpp_f<0x128>(v); v += dpp_f<0x124>(v); v += dpp_f<0x122>(v); v += dpp_f<0x121>(v); return v; }
__device__ __forceinline__ float rdlane(float v, int l) { return __int_as_float(__builtin_amdgcn_readlane(__float_as_int(v), l)); }
__device__ __forceinline__ float wave_sum64(float v) { v = row_sum16(v); return (rdlane(v, 0) + rdlane(v, 16)) + (rdlane(v, 32) + rdlane(v, 48)); }

namespace pg8 {
constexpr int BM = 256, BK = 64, HALF = 128, HTB = HALF * BK * 2, STAGE_BYTES = 8 * HTB, NXCD = 8, WGM = 8;
__host__ __device__ __forceinline__ int lds_byte(int r, int c) { const int st = (r >> 4) * 2 + (c >> 5), rr = r & 15, cc = c & 31, ob = rr * 64 + cc * 2; return st * 1024 + (ob ^ (((ob >> 9) & 1) << 5)); }
__host__ __device__ __forceinline__ void stage_rc(int b, int& R, int& C) { const int st = b / 1024, sb = b % 1024, swz = sb ^ (((sb >> 9) & 1) << 5); R = (st >> 1) * 16 + swz / 64; C = (st & 1) * 32 + (swz % 64) / 2; }
__host__ __device__ __forceinline__ int perm32(int rho) { const int n = rho >> 4, i = rho & 15; return 8 * (i >> 2) + 4 * n + (i & 3); }
struct Unit { int pm, pn; };
struct Gemm { const bf16_t* A; const bf16_t* Bt; int M, N, K, lda; };
struct StaticOrder {
    int nM, nN, nwg, G, c;
    __device__ void init(int M, int N, int G_, int c_) { nM = M / BM; nN = N / BM; nwg = nM * nN; G = G_; c = c_; }
    __device__ bool next(int i, Unit& u) const {
        const long L = (long)i * G + c; if (L >= nwg) return false;
        int wgid = (int)L; { const int q = nwg / NXCD, r = nwg % NXCD, xcd = wgid % NXCD, off = wgid / NXCD; wgid = (xcd < r ? xcd * (q + 1) : r * (q + 1) + (xcd - r) * q) + off; }
        const int nig = WGM * nN, gid = wgid / nig, fm = gid * WGM, gsz = (nM - fm) < WGM ? (nM - fm) : WGM;
        u.pm = fm + ((wgid % nig) % gsz); u.pn = (wgid % nig) / gsz; return true;
    }
};
template <class Epi>
__device__ __forceinline__ void gemm_phase(LAS unsigned char* lds, const Gemm g, const StaticOrder& S, const Epi& E) {
    const int tid = threadIdx.x, wid = __builtin_amdgcn_readfirstlane(tid >> 6), lane = tid & 63, wr = wid >> 2, wc = wid & 3, fr = lane & 15, fq = lane >> 4;
    const int K = g.K, nt = K / BK;
    unsigned voffA[2], voffB[2];
#pragma unroll
    for (int i = 0; i < 2; ++i) { int R, C; stage_rc(tid * 16 + i * 8192, R, C); const int Rb = (R & ~31) + perm32(R & 31);
        voffA[i] = (unsigned)(R * g.lda + C) * 2u; voffB[i] = (unsigned)(Rb * K + C) * 2u; }
    const size_t kstep = (size_t)(BK * 2);
    const size_t hsA = (size_t)HALF * g.lda * 2, hsB = (size_t)HALF * K * 2;
    const size_t tsA = 2 * hsA, tsB = 2 * hsB;
    const unsigned ldsw = (unsigned)wid * 1024u;
    const int aoff = lds_byte(wr * 64 + fr, fq * 8), boff = lds_byte(wc * 32 + fr, fq * 8);
#define PG8_SA(b, h) (((b) * 2 + (h)) * HTB)
#define PG8_SB(b, h) ((4 + (b) * 2 + (h)) * HTB)
#define PG8_STAGE(bufoff, gbase, voff) do { _Pragma("unroll") for (int _i = 0; _i < 2; ++_i) \
        __builtin_amdgcn_global_load_lds((const unsigned*)((const char*)(gbase) + (voff)[_i]), (LAS unsigned*)(lds + (bufoff) + ldsw + _i * 8192), 16, 0, 0); } while (0)
#define PG8_LDA(dst, b, h) do { _Pragma("unroll") for (int m = 0; m < 4; ++m) _Pragma("unroll") for (int k = 0; k < 2; ++k) dst[m][k] = *(const LAS bf16x8*)(lds + PG8_SA(b, h) + aoff + m * 2048 + k * 1024); } while (0)
#define PG8_LDB(dst, b, h) do { _Pragma("unroll") for (int n = 0; n < 2; ++n) _Pragma("unroll") for (int k = 0; k < 2; ++k) dst[n][k] = *(const LAS bf16x8*)(lds + PG8_SB(b, h) + boff + n * 2048 + k * 1024); } while (0)
#define PG8_MMA(ai, bj, At, Bt) do { __builtin_amdgcn_s_setprio(1); _Pragma("unroll") for (int m = 0; m < 4; ++m) _Pragma("unroll") for (int n = 0; n < 2; ++n) _Pragma("unroll") for (int k = 0; k < 2; ++k) \
        acc[ai][bj][m][n] = __builtin_amdgcn_mfma_f32_16x16x32_bf16(Bt[n][k], At[m][k], acc[ai][bj][m][n], 0, 0, 0); __builtin_amdgcn_s_setprio(0); } while (0)
#define PG8_WAIT_V(n) asm volatile("s_waitcnt vmcnt(" #n ")" ::: "memory")
#define PG8_WAIT_L(n) asm volatile("s_waitcnt lgkmcnt(" #n ")" ::: "memory")
#define PG8_BAR __builtin_amdgcn_s_barrier()
#define PG8_SCHED __builtin_amdgcn_sched_barrier(0)
    Unit cur, nxt; int ui = 0;
    if (!S.next(0, cur)) return;
    f32x4 acc[2][2][4][2];
#pragma unroll
    for (int a = 0; a < 2; ++a)
#pragma unroll
        for (int b = 0; b < 2; ++b)
#pragma unroll
            for (int m = 0; m < 4; ++m)
#pragma unroll
                for (int n = 0; n < 2; ++n) acc[a][b][m][n] = (f32x4){0.f, 0.f, 0.f, 0.f};
    bf16x8 At[4][2], B0[2][2], B1[2][2];
    const char* cA = (const char*)g.A + (size_t)cur.pm * tsA; const char* cB = (const char*)g.Bt + (size_t)cur.pn * tsB;
    PG8_STAGE(PG8_SB(0, 0), cB, voffB); PG8_STAGE(PG8_SA(0, 0), cA, voffA); PG8_STAGE(PG8_SB(0, 1), cB + hsB, voffB); PG8_STAGE(PG8_SA(0, 1), cA + hsA, voffA);
    if (wr == 1) PG8_BAR;
    PG8_WAIT_V(4); PG8_BAR;
    PG8_STAGE(PG8_SB(1, 0), cB + kstep, voffB); PG8_STAGE(PG8_SA(1, 0), cA + kstep, voffA); PG8_STAGE(PG8_SB(1, 1), cB + hsB + kstep, voffB);
    PG8_WAIT_V(6); PG8_BAR;
    for (;;) {
        const bool has_next = S.next(ui + 1, nxt);
        const char* nA = has_next ? (const char*)g.A + (size_t)nxt.pm * tsA : cA; const char* nB = has_next ? (const char*)g.Bt + (size_t)nxt.pn * tsB : cB;
        for (int t = 0; t < nt; t += 2) {
            const bool last = (t == nt - 2);
            const char* a1 = cA + (size_t)(t + 1) * kstep;
            const char* a2 = last ? nA : cA + (size_t)(t + 2) * kstep; const char* b2 = last ? nB : cB + (size_t)(t + 2) * kstep;
            const char* a3 = a2 + kstep; const char* b3 = b2 + kstep;
            PG8_LDB(B0, 0, 0); PG8_SCHED; PG8_LDA(At, 0, 0); PG8_STAGE(PG8_SA(1, 1), a1 + hsA, voffA);
            PG8_WAIT_L(8); PG8_BAR; PG8_WAIT_L(0); PG8_MMA(0, 0, At, B0); PG8_BAR; PG8_SCHED;
            PG8_LDB(B1, 0, 1); PG8_STAGE(PG8_SB(0, 0), b2, voffB);
            PG8_BAR; PG8_WAIT_L(0); PG8_MMA(0, 1, At, B1); PG8_BAR;
            PG8_LDA(At, 0, 1); PG8_STAGE(PG8_SA(0, 0), a2, voffA);
            PG8_BAR; PG8_WAIT_L(0); PG8_MMA(1, 0, At, B0); PG8_BAR; PG8_SCHED;
            PG8_STAGE(PG8_SB(0, 1), b2 + hsB, voffB);
            PG8_WAIT_V(6); PG8_BAR; PG8_MMA(1, 1, At, B1); PG8_BAR;
            PG8_LDB(B0, 1, 0); PG8_SCHED; PG8_LDA(At, 1, 0); PG8_STAGE(PG8_SA(0, 1), a2 + hsA, voffA);
            PG8_WAIT_L(8); PG8_BAR; PG8_WAIT_L(0); PG8_MMA(0, 0, At, B0); PG8_BAR; PG8_SCHED;
            PG8_LDB(B1, 1, 1); PG8_STAGE(PG8_SB(1, 0), b3, voffB);
            PG8_BAR; PG8_WAIT_L(0); PG8_MMA(0, 1, At, B1); PG8_BAR;
            PG8_LDA(At, 1, 1); PG8_STAGE(PG8_SA(1, 0), a3, voffA);
            PG8_BAR; PG8_WAIT_L(0); PG8_MMA(1, 0, At, B0); PG8_BAR; PG8_SCHED;
            PG8_STAGE(PG8_SB(1, 1), b3 + hsB, voffB);
            PG8_WAIT_V(6); PG8_BAR; PG8_MMA(1, 1, At, B1); PG8_BAR;
        }
        E(acc, cur, wr, wc, fr, fq);
        if (!has_next) break;
#pragma unroll
        for (int a = 0; a < 2; ++a)
#pragma unroll
            for (int b = 0; b < 2; ++b)
#pragma unroll
                for (int m = 0; m < 4; ++m)
#pragma unroll
                    for (int n = 0; n < 2; ++n) acc[a][b][m][n] = (f32x4){0.f, 0.f, 0.f, 0.f};
        cur = nxt; cA = nA; cB = nB; ++ui;
    }
    PG8_WAIT_V(0);
    if (wr == 0) PG8_BAR;
    PG8_BAR;
#undef PG8_SA
#undef PG8_SB
#undef PG8_STAGE
#undef PG8_LDA
#undef PG8_LDB
#undef PG8_MMA
#undef PG8_WAIT_V
#undef PG8_WAIT_L
#undef PG8_BAR
#undef PG8_SCHED
}
struct EpiProj {
    bf16_t* P; const float* rstd;
    __device__ __forceinline__ void operator()(const f32x4 (&acc)[2][2][4][2], const Unit& u, int wr, int wc, int fr, int fq) const {
        const int row0 = u.pm * BM + wr * 64 + fr, col0 = u.pn * BM + wc * 32 + 8 * fq;
#pragma unroll
        for (int ai = 0; ai < 2; ++ai)
#pragma unroll
            for (int m = 0; m < 4; ++m) { const int r = row0 + ai * HALF + m * 16; const float rs = rstd[r]; bf16_t* rowp = P + (size_t)r * NPROJ + col0;
#pragma unroll
                for (int bj = 0; bj < 2; ++bj) { if (col0 + bj * HALF < NPROJ) { const f32x4 v0 = acc[ai][bj][m][0] * rs, v1 = acc[ai][bj][m][1] * rs;
                    u32x4 o; o.x = pk_bf16(v0[0], v0[1]); o.y = pk_bf16(v0[2], v0[3]); o.z = pk_bf16(v1[0], v1[1]); o.w = pk_bf16(v1[2], v1[3]);
                    *(u32x4*)(rowp + bj * HALF) = o; } } }
    }
};
struct EpiResid {
    float* X; bf16_t* XB;
    __device__ __forceinline__ void operator()(const f32x4 (&acc)[2][2][4][2], const Unit& u, int wr, int wc, int fr, int fq) const {
        const int row0 = u.pm * BM + wr * 64 + fr, col0 = u.pn * BM + wc * 32 + 8 * fq;
#pragma unroll
        for (int ai = 0; ai < 2; ++ai)
#pragma unroll
            for (int m = 0; m < 4; ++m) { const size_t off = (size_t)(row0 + ai * HALF + m * 16) * DM + col0;
#pragma unroll
                for (int bj = 0; bj < 2; ++bj) { float* xp = X + off + bj * HALF;
                    const f32x4 v0 = *(const f32x4*)xp + acc[ai][bj][m][0], v1 = *(const f32x4*)(xp + 4) + acc[ai][bj][m][1];
                    *(f32x4*)xp = v0; *(f32x4*)(xp + 4) = v1;
                    u32x4 o; o.x = pk_bf16(v0[0], v0[1]); o.y = pk_bf16(v0[2], v0[3]); o.z = pk_bf16(v1[0], v1[1]); o.w = pk_bf16(v1[2], v1[3]);
                    *(u32x4*)(XB + off + bj * HALF) = o; }
                asm volatile("" ::: "memory"); }
    }
};
struct EpiF32 {
    float* C; int ldc;
    __device__ __forceinline__ void operator()(const f32x4 (&acc)[2][2][4][2], const Unit& u, int wr, int wc, int fr, int fq) const {
        const int row0 = u.pm * BM + wr * 64 + fr, col0 = u.pn * BM + wc * 32 + 8 * fq;
#pragma unroll
        for (int ai = 0; ai < 2; ++ai)
#pragma unroll
            for (int m = 0; m < 4; ++m) { float* rowp = C + (size_t)(row0 + ai * HALF + m * 16) * ldc + col0;
#pragma unroll
                for (int bj = 0; bj < 2; ++bj) { *(f32x4*)(rowp + bj * HALF) = acc[ai][bj][m][0]; *(f32x4*)(rowp + bj * HALF + 4) = acc[ai][bj][m][1]; } }
    }
};
}

struct Args { const float* in[26]; float* out; unsigned char* ws; int lo, hi; };
enum { I_X = 0, I_NMIX, I_NFFN, I_NFIN, I_WIN, I_WOUT, I_GCONV, I_GALOG, I_GDT, I_GNORM, I_HLB, I_HNORM, I_LCONVW, I_LCONVB, I_LWA, I_LBA, I_LWX, I_LBX, I_LLAM,
       I_DWG, I_DBG, I_DNORM, I_PWQ, I_PKEYS, I_PU, I_PV };
constexpr int NTHREADS = 512, NWAVES = 8;
constexpr int LDS_MISC = pg8::STAGE_BYTES;
constexpr int LDS_BYTES = pg8::STAGE_BYTES + 64;

__device__ __forceinline__ int win_srccol(int d) {
    if (d < 1536) return d;
    if (d < 3072) return d + 520;
    if (d < 3584) return d + 1032;
    if (d < 4608) return d + 1544;
    if (d < 5120) return d - 3072;
    if (d < 5632) return d - 1528;
    if (d < 6144) return d - 1016;
    if (d < 6656) return d + 8;
    if (d < 6664) return d - 4608;
    if (d < 6680) return d;
    return -1;
}
template <int MAP>
__device__ __forceinline__ void p0_transpose_item(const float* W, int K, int ldw, int nblk, bf16_t* WT, const float* rowscale, LAS float* scr, int item, int lane) {
    const int kb = item / nblk, nb = item % nblk, k0 = 64 * kb, n0 = 32 * nb;
    int sc = n0 + (lane & 31);
    if (MAP == 1) sc = win_srccol(sc);
#pragma unroll 8
    for (int i = 0; i < 32; ++i) { const int kk = 2 * i + (lane >> 5);
        float v = 0.f;
        if (sc >= 0) { v = W[(size_t)(k0 + kk) * ldw + sc]; if (rowscale) v *= rowscale[k0 + kk]; }
        scr[kk * 33 + (lane & 31)] = v; }
    asm volatile("s_waitcnt lgkmcnt(0)" ::: "memory");
    const int c = lane & 7;
#pragma unroll
    for (int j = 0; j < 4; ++j) { const int n = (lane >> 3) + 8 * j; const LAS float* s = scr + (8 * c) * 33 + n;
        u32x4 o; o.x = pk_bf16(s[0 * 33], s[1 * 33]); o.y = pk_bf16(s[2 * 33], s[3 * 33]); o.z = pk_bf16(s[4 * 33], s[5 * 33]); o.w = pk_bf16(s[6 * 33], s[7 * 33]);
        *(u32x4*)(WT + (size_t)(n0 + n) * K + k0 + 8 * c) = o; }
    asm volatile("s_waitcnt lgkmcnt(0)" ::: "memory");
}
__device__ __forceinline__ void convert_table(const float* src, bf16_t* dst, size_t n, int gtid, int gthreads) {
    const size_t n8 = n / 8;
    for (size_t i = gtid; i < n8; i += gthreads) { const f32x4 a = *(const f32x4*)(src + i * 8), b = *(const f32x4*)(src + i * 8 + 4);
        u32x4 o; o.x = pk_bf16(a[0], a[1]); o.y = pk_bf16(a[2], a[3]); o.z = pk_bf16(b[0], b[1]); o.w = pk_bf16(b[2], b[3]);
        *(u32x4*)(dst + i * 8) = o; }
}
__device__ __forceinline__ void p0_prologue(const Args& A, LAS unsigned char* lds) {
    const int tid = threadIdx.x, lane = tid & 63, wave = __builtin_amdgcn_readfirstlane(tid >> 6), G = gridDim.x, bx = blockIdx.x;
    const int gw = bx * NWAVES + wave, NGW = G * NWAVES;
    unsigned char* ws = A.ws;
    {
        float* X = A.out; bf16_t* XB = (bf16_t*)(ws + WS_XB); float* rstd1 = (float*)(ws + WS_RSTD1);
        for (int row = gw; row < MTOK; row += NGW) {
            const f32x4* xr = (const f32x4*)(A.in[I_X] + (size_t)row * DM) + lane; f32x4 v[4]; float s = 0.f;
#pragma unroll
            for (int j = 0; j < 4; ++j) { v[j] = xr[64 * j]; s += (v[j].x * v[j].x + v[j].y * v[j].y) + (v[j].z * v[j].z + v[j].w * v[j].w); }
            s = wave_sum64(s);
            f32x4* xo = (f32x4*)(X + (size_t)row * DM) + lane; u32x2* bo = (u32x2*)(XB + (size_t)row * DM) + lane;
#pragma unroll
            for (int j = 0; j < 4; ++j) { xo[64 * j] = v[j]; u32x2 o; o.x = pk_bf16(v[j].x, v[j].y); o.y = pk_bf16(v[j].z, v[j].w); bo[64 * j] = o; }
            if (lane == 0) rstd1[row] = rsqrtf(s * (1.f / DM) + EPS);
        }
    }
    {
        LAS float* scr = (LAS float*)(lds + wave * 8704);
        constexpr int NB_IN = NPROJP / 32, I_IN = (DM / 64) * NB_IN, NB_OUT = DM / 32, I_OUT = (2048 / 64) * NB_OUT;
        constexpr int NITEMS = NLAYER * (I_IN + I_OUT);
        for (int it = gw; it < NITEMS; it += NGW) {
            int r = it; const int l = r / (I_IN + I_OUT); r -= l * (I_IN + I_OUT);
            if (r < I_IN) p0_transpose_item<1>(A.in[I_WIN] + (size_t)l * DM * NPROJ, DM, NPROJ, NB_IN, (bf16_t*)(ws + WS_WIN) + (size_t)l * NPROJP * DM, A.in[I_NMIX] + l * DM, scr, r, lane);
            else p0_transpose_item<0>(A.in[I_WOUT] + (size_t)l * 2048 * DM, 2048, DM, NB_OUT, (bf16_t*)(ws + WS_WOUT) + (size_t)l * DM * 2048, nullptr, scr, r - I_IN, lane);
        }
    }
    __syncthreads();
    {
        LAS float* key_s = (LAS float*)lds; LAS float* wq_s = key_s + 128 * 129;
        for (int it = bx; it < NLAYER * 16 * 16; it += G) {
            const int l = it >> 8, hp = (it >> 4) & 15, k0 = (it & 15) * 64;
            const float* keys = A.in[I_PKEYS] + ((size_t)l * 16 + hp) * 128 * 128;
            const float* wq = A.in[I_PWQ] + (size_t)l * DM * 2048 + (size_t)k0 * 2048 + hp * 128;
            for (int e = tid; e < 128 * 128; e += NTHREADS) key_s[(e >> 7) * 129 + (e & 127)] = keys[e];
            for (int e = tid; e < 64 * 128; e += NTHREADS) wq_s[(e >> 7) * 129 + (e & 127)] = wq[(size_t)(e >> 7) * 2048 + (e & 127)];
            __syncthreads();
            const int ks = (tid & 15) * 4, ys = (tid >> 4) * 4;
            float acc[4][4];
#pragma unroll
            for (int i = 0; i < 4; ++i)
#pragma unroll
                for (int j = 0; j < 4; ++j) acc[i][j] = 0.f;
            for (int d = 0; d < 128; ++d) { float a[4], b[4];
#pragma unroll
                for (int i = 0; i < 4; ++i) { a[i] = wq_s[(ks + i) * 129 + d]; b[i] = key_s[(ys + i) * 129 + d]; }
#pragma unroll
                for (int i = 0; i < 4; ++i)
#pragma unroll
                    for (int j = 0; j < 4; ++j) acc[i][j] += a[i] * b[j]; }
            const float* nf = A.in[I_NFFN] + l * DM + k0 + ks;
            bf16_t* wt = (bf16_t*)(ws + WS_WEFF) + (size_t)l * 2048 * DM;
#pragma unroll
            for (int j = 0; j < 4; ++j) { u32x2 o; o.x = pk_bf16(acc[0][j] * nf[0], acc[1][j] * nf[1]); o.y = pk_bf16(acc[2][j] * nf[2], acc[3][j] * nf[3]);
                *(u32x2*)(wt + (size_t)(hp * 128 + ys + j) * DM + k0 + ks) = o; }
            __syncthreads();
        }
    }
    {
        bf16_t* wt = (bf16_t*)(ws + WS_LRUW);
        for (int e = bx * NTHREADS + tid; e < NLAYER * 2 * 4 * 128 * 128; e += G * NTHREADS) {
            const int k = e & 127, n = (e >> 7) & 127, g = (e >> 14) & 3, mat = (e >> 16) & 1, l = e >> 17;
            const float* src = A.in[mat ? I_LWX : I_LWA] + (((size_t)l * 4 + g) * 128 + k) * 128 + n;
            wt[e] = to_bf1(*src);
        }
    }
}

__device__ __forceinline__ void convert_tables(const Args& A, int l) {
    const int tid = threadIdx.x, lane = tid & 63, wave = __builtin_amdgcn_readfirstlane(tid >> 6), G = gridDim.x, bx = blockIdx.x;
    const int gw = bx * NWAVES + wave, NGW = G * NWAVES;
    unsigned char* ws = A.ws;
    for (int row = gw; row < 2 * 16384; row += NGW) {
        const int tbl = row >> 14, rr = row & 16383;
        const float* src = A.in[tbl ? I_PV : I_PU] + ((size_t)l * 16384 + rr) * DM + 16 * lane;
        f32x4 v[4]; float mx = 0.f;
#pragma unroll
        for (int j = 0; j < 4; ++j) { v[j] = *(const f32x4*)(src + 4 * j); mx = fmaxf(fmaxf(mx, fmaxf(fabsf(v[j].x), fabsf(v[j].y))), fmaxf(fabsf(v[j].z), fabsf(v[j].w))); }
        mx = fmaxf(mx, dpp_f<0x128>(mx)); mx = fmaxf(mx, dpp_f<0x124>(mx)); mx = fmaxf(mx, dpp_f<0x122>(mx)); mx = fmaxf(mx, dpp_f<0x121>(mx));
        mx = fmaxf(fmaxf(rdlane(mx, 0), rdlane(mx, 16)), fmaxf(rdlane(mx, 32), rdlane(mx, 48)));
        mx = fmaxf(mx, 1e-30f);
        const float sc = 6.f / mx;
        u32x2 o; unsigned p;
        p = 0u; p = __builtin_amdgcn_cvt_scalef32_pk_fp4_f32(p, v[0].x * sc, v[0].y * sc, 1.0f, 0); p = __builtin_amdgcn_cvt_scalef32_pk_fp4_f32(p, v[0].z * sc, v[0].w * sc, 1.0f, 1);
        p = __builtin_amdgcn_cvt_scalef32_pk_fp4_f32(p, v[1].x * sc, v[1].y * sc, 1.0f, 2); p = __builtin_amdgcn_cvt_scalef32_pk_fp4_f32(p, v[1].z * sc, v[1].w * sc, 1.0f, 3); o.x = p;
        p = 0u; p = __builtin_amdgcn_cvt_scalef32_pk_fp4_f32(p, v[2].x * sc, v[2].y * sc, 1.0f, 0); p = __builtin_amdgcn_cvt_scalef32_pk_fp4_f32(p, v[2].z * sc, v[2].w * sc, 1.0f, 1);
        p = __builtin_amdgcn_cvt_scalef32_pk_fp4_f32(p, v[3].x * sc, v[3].y * sc, 1.0f, 2); p = __builtin_amdgcn_cvt_scalef32_pk_fp4_f32(p, v[3].z * sc, v[3].w * sc, 1.0f, 3); o.y = p;
        *(u32x2*)(ws + (tbl ? WS_V8 : WS_U8) + (size_t)rr * (DM / 2) + 8 * lane) = o;
        if (lane == 0) ((float*)(ws + (tbl ? WS_SV : WS_SU)))[rr] = mx * (1.f / 6.f);
    }
}

__device__ __forceinline__ void load8(const bf16_t* p, float (&f)[8]) { unpack8(*(const u32x4*)p, f); }
__device__ __forceinline__ float hgrn_lb(const Args& A, int l, int c) {
    if (l == 0) return 0.f;
    const float* lg = A.in[I_HLB]; return sigmoidf_(lg[512 + c] - lg[c]);
}
typedef bf16x8 frag_t;
#define MFMA16(a_, b_, c_) __builtin_amdgcn_mfma_f32_16x16x32_bf16((a_), (b_), (c_), 0, 0, 0)
constexpr int XCS = 520;
constexpr int P136 = 136, P72 = 72, P68 = 68;
constexpr int LDS_SMALL = 122880;
template <int DK>
__device__ __forceinline__ void k1_gla_head(const Args& A, LAS unsigned char* lds, int l, int h, int r0, int ci, bf16_t* proj, unsigned char* aux) {
    constexpr bool HG = (DK == 128);
    constexpr int NSEG = NTHREADS / DK, TPS = 64 / NSEG, PD = DK + 8;
    const int tid = threadIdx.x, lane = tid & 63, wave = __builtin_amdgcn_readfirstlane(tid >> 6), c = tid % DK, seg = tid / DK;
    LAS bf16_t* Q1L = (LAS bf16_t*)lds; LAS bf16_t* K1L = Q1L + 64 * PD; LAS float* segsum = (LAS float*)(K1L + 64 * PD);
    const int qcol = (HG ? C_BQ : C_DQ) + h * DK + c, kcol = (HG ? C_BF : C_DK) + h * DK + c;
    float lbv = 0.f, wg[16], bgv = 0.f;
    if (HG) lbv = hgrn_lb(A, l, h * 128 + c);
    else { const float* wgp = A.in[I_DWG] + (size_t)l * 16 * 256 + h * 64 + c;
#pragma unroll
        for (int r = 0; r < 16; ++r) wg[r] = wgp[r * 256];
        bgv = A.in[I_DBG][l * 256 + h * 64 + c]; }
    LAS bf16_t* LRL = (LAS bf16_t*)(segsum + NSEG * DK);
    {
        constexpr int CPR = DK / 8, NPT = 64 * CPR / NTHREADS;
#pragma unroll
        for (int i = 0; i < NPT; ++i) { const int e = tid + i * NTHREADS, r = e / CPR, cc = (e % CPR) * 8; const bf16_t* pr = proj + (size_t)(r0 + r) * NPROJ;
            *(LAS u32x4*)(Q1L + r * PD + cc) = *(const u32x4*)(pr + (HG ? C_BQ : C_DQ) + h * DK + cc);
            *(LAS u32x4*)(K1L + r * PD + cc) = *(const u32x4*)(pr + (HG ? C_BF : C_DK) + h * DK + cc); }
        if (!HG && tid < 128) { const int r = tid >> 1, cc = (tid & 1) * 8; *(LAS u32x4*)(LRL + r * 16 + cc) = *(const u32x4*)(proj + (size_t)(r0 + r) * NPROJ + C_DLR + cc); }
    }
    __syncthreads();
#define K1_TOKEN(t_, qv_, kv_, lg_) do { const float qr_ = bf1(Q1L[(t_) * PD + c]), kr_ = bf1(K1L[(t_) * PD + c]); \
        if (HG) { qv_ = siluf_(qr_); kv_ = (1.f - lbv) * sigmoidf_(-kr_); lg_ = log1pf(-kv_); } \
        else { qv_ = qr_; kv_ = kr_; float t8_[8]; float z_ = bgv; unpack8(*(const LAS u32x4*)(LRL + (t_) * 16), t8_); \
            _Pragma("unroll") for (int r_ = 0; r_ < 8; ++r_) z_ = fmaf(t8_[r_], wg[r_], z_); \
            unpack8(*(const LAS u32x4*)(LRL + (t_) * 16 + 8), t8_); \
            _Pragma("unroll") for (int r_ = 0; r_ < 8; ++r_) z_ = fmaf(t8_[r_], wg[8 + r_], z_); \
            lg_ = -softplusf_(-z_) * (1.f / 16.f); } } while (0)
    {
        float run = 0.f;
#pragma unroll 4
        for (int i = 0; i < TPS; ++i) { float qv, kv, lg; K1_TOKEN(seg * TPS + i, qv, kv, lg); run += lg; asm volatile("" :: "v"(qv), "v"(kv)); }
        segsum[seg * DK + c] = run;
    }
    __syncthreads();
    float off = 0.f, bref = 0.f, blast = 0.f;
#pragma unroll
    for (int s2 = 0; s2 < NSEG; ++s2) { const float v = segsum[s2 * DK + c]; if (s2 < seg) off += v; if (s2 < NSEG / 2) bref += v; blast += v; }
    {
        bf16_t* ktp = (bf16_t*)(aux + (HG ? AX_HKT : AX_DKT)) + ((size_t)ci * DK + c) * 64 + seg * TPS;
        float run = off;
#pragma unroll 1
        for (int i8 = 0; i8 < TPS; i8 += 8) { float k2[8];
#pragma unroll
            for (int i = 0; i < 8; ++i) { const int t = seg * TPS + i8 + i; float qv, kv, lg; K1_TOKEN(t, qv, kv, lg); run += lg; const float b = run;
                Q1L[t * PD + c] = to_bf1(qv * __expf(b - bref)); K1L[t * PD + c] = to_bf1(kv * __expf(bref - b));
                proj[(size_t)(r0 + t) * NPROJ + qcol] = to_bf1(qv * __expf(b));
                k2[i] = kv * __expf(blast - b); }
            u32x4 o; o.x = pk_bf16(k2[0], k2[1]); o.y = pk_bf16(k2[2], k2[3]); o.z = pk_bf16(k2[4], k2[5]); o.w = pk_bf16(k2[6], k2[7]); *(u32x4*)(ktp + i8) = o; }
        if (seg == 0) ((float*)(aux + (HG ? AX_HGD : AX_DGD)))[(size_t)ci * DK + c] = __expf(blast);
    }
#undef K1_TOKEN
    __syncthreads();
    {
        const int fr = lane & 15, fq = lane >> 4;
        bf16_t* att = (bf16_t*)(aux + (HG ? AX_HATT : AX_DATT)) + (size_t)ci * 64 * 64;
#pragma unroll
        for (int tt = 0; tt < 2; ++tt) { const int id = wave * 2 + tt, mi = id >> 2, nj = id & 3;
            f32x4 acc = {0.f, 0.f, 0.f, 0.f};
            if (nj <= mi) {
#pragma unroll
                for (int ks = 0; ks < DK / 32; ++ks) { const frag_t a = *(const LAS frag_t*)(Q1L + (mi * 16 + fr) * PD + ks * 32 + fq * 8), b = *(const LAS frag_t*)(K1L + (nj * 16 + fr) * PD + ks * 32 + fq * 8);
                    acc = MFMA16(a, b, acc); } }
#pragma unroll
            for (int r = 0; r < 4; ++r) { const int i = mi * 16 + fq * 4 + r, j = nj * 16 + fr; att[i * 64 + j] = to_bf1(j <= i ? acc[r] : 0.f); } }
    }
    __syncthreads();
}
__device__ __forceinline__ void b1_prep(const Args& A, LAS unsigned char* lds, int l, int half) {
    const int tid = threadIdx.x, lane = tid & 63, wave = __builtin_amdgcn_readfirstlane(tid >> 6), G = gridDim.x, fr = lane & 15, fq = lane >> 4;
    bf16_t* proj = (bf16_t*)(A.ws + WS_PROJ); unsigned char* aux = A.ws + WS_AUX;
    LAS bf16_t* xc = (LAS bf16_t*)lds;
    LAS float* sg = (LAS float*)(lds + LDS_SMALL);
    LAS float* sb = sg + 256;
    LAS float* sgc = sb + 256;
    for (int tile = blockIdx.x; tile < HM / 64; tile += G) {
        const int r0 = tile * 64, t0 = (tile & 63) * 64, bb = tile >> 6, chunk = tile & 63;
        for (int u = wave; u < 24; u += NWAVES) {
            const int p = u >> 3, ch = u & 7, c = p * 512 + lane * 8, ts = t0 + ch * 8, rs = r0 + ch * 8;
            const float* cwp = A.in[I_GCONV] + (size_t)l * 4 * 1536 + c;
            float cw[4][8];
#pragma unroll
            for (int w = 0; w < 4; ++w) { const f32x4 a = *(const f32x4*)(cwp + w * 1536), b = *(const f32x4*)(cwp + w * 1536 + 4);
                cw[w][0] = a[0]; cw[w][1] = a[1]; cw[w][2] = a[2]; cw[w][3] = a[3]; cw[w][4] = b[0]; cw[w][5] = b[1]; cw[w][6] = b[2]; cw[w][7] = b[3]; }
            float x3[8], x2[8], x1[8], x0[8];
            if (ts >= 3) { load8(proj + (size_t)(rs - 3) * NPROJ + c, x3); load8(proj + (size_t)(rs - 2) * NPROJ + c, x2); load8(proj + (size_t)(rs - 1) * NPROJ + c, x1); }
            else {
#pragma unroll
                for (int j = 0; j < 8; ++j) { x3[j] = 0.f; x2[j] = 0.f; x1[j] = 0.f; } }
            const int ci = (bb * 4 + (lane >> 4)) * 64 + chunk;
            bf16_t* dst = (bf16_t*)(aux + (p == 0 ? AX_GQ : (p == 1 ? AX_GW : AX_GO))) + ((size_t)ci * 64 + ch * 8) * 128 + (lane & 15) * 8;
#pragma unroll
            for (int i = 0; i < 8; ++i) {
                load8(proj + (size_t)(rs + i) * NPROJ + c, x0);
                float o[8]; float ss = 0.f;
#pragma unroll
                for (int j = 0; j < 8; ++j) { const float v = cw[0][j] * x3[j] + cw[1][j] * x2[j] + cw[2][j] * x1[j] + cw[3][j] * x0[j]; o[j] = siluf_(v); ss += o[j] * o[j]; }
                if (p < 2) { ss = row_sum16(ss); const float sc = rsqrtf(ss + EPS);
#pragma unroll
                    for (int j = 0; j < 8; ++j) o[j] *= sc; }
                *(u32x4*)(dst + (size_t)i * 128) = pack8(o);
#pragma unroll
                for (int j = 0; j < 8; ++j) { x3[j] = x2[j]; x2[j] = x1[j]; x1[j] = x0[j]; }
            }
        }
        if (tid < 256) { const int tk = tid & 63, h = tid >> 6; const size_t row = (size_t)(r0 + tk);
            const float a = bf1(proj[row * NPROJ + C_AA + h]), b = bf1(proj[row * NPROJ + C_AB + h]);
            sg[h * 64 + tk] = -__expf(A.in[I_GALOG][l * 4 + h]) * softplusf_(a + A.in[I_GDT][l * 4 + h]); sb[h * 64 + tk] = sigmoidf_(b); }
        { const int ch = wave, c = lane * 8, ts = t0 + ch * 8, rs = r0 + ch * 8;
            const float* cwp = A.in[I_LCONVW] + (size_t)l * 4 * 512 + c; const float* cbp = A.in[I_LCONVB] + l * 512 + c;
            float cw[4][8], cb[8];
#pragma unroll
            for (int w = 0; w < 4; ++w) { const f32x4 a = *(const f32x4*)(cwp + w * 512), b = *(const f32x4*)(cwp + w * 512 + 4);
                cw[w][0] = a[0]; cw[w][1] = a[1]; cw[w][2] = a[2]; cw[w][3] = a[3]; cw[w][4] = b[0]; cw[w][5] = b[1]; cw[w][6] = b[2]; cw[w][7] = b[3]; }
            { const f32x4 a = *(const f32x4*)cbp, b = *(const f32x4*)(cbp + 4); cb[0] = a[0]; cb[1] = a[1]; cb[2] = a[2]; cb[3] = a[3]; cb[4] = b[0]; cb[5] = b[1]; cb[6] = b[2]; cb[7] = b[3]; }
            float x3[8], x2[8], x1[8], x0[8];
            const bf16_t* src = proj + C_CX + c;
            if (ts >= 3) { load8(src + (size_t)(rs - 3) * NPROJ, x3); load8(src + (size_t)(rs - 2) * NPROJ, x2); load8(src + (size_t)(rs - 1) * NPROJ, x1); }
            else {
#pragma unroll
                for (int j = 0; j < 8; ++j) { x3[j] = 0.f; x2[j] = 0.f; x1[j] = 0.f; } }
#pragma unroll
            for (int i = 0; i < 8; ++i) {
                load8(src + (size_t)(rs + i) * NPROJ, x0);
                float o[8];
#pragma unroll
                for (int j = 0; j < 8; ++j) o[j] = cb[j] + cw[0][j] * x3[j] + cw[1][j] * x2[j] + cw[2][j] * x1[j] + cw[3][j] * x0[j];
                *(LAS u32x4*)(xc + (ch * 8 + i) * XCS + c) = pack8(o);
#pragma unroll
                for (int j = 0; j < 8; ++j) { x3[j] = x2[j]; x2[j] = x1[j]; x1[j] = x0[j]; }
            }
        }
        __syncthreads();
        { const int g = wave >> 1, nh = wave & 1;
            const bf16_t* wa = (const bf16_t*)(A.ws + WS_LRUW) + (((size_t)l * 2 + 0) * 4 + g) * 128 * 128;
            const bf16_t* wx = (const bf16_t*)(A.ws + WS_LRUW) + (((size_t)l * 2 + 1) * 4 + g) * 128 * 128;
            bf16_t* lom = (bf16_t*)(aux + AX_LOM); bf16_t* lbb = (bf16_t*)(aux + AX_LB);
#pragma unroll 1
            for (int nt = 0; nt < 4; ++nt) {
                const int n = nh * 64 + nt * 16 + fr, cch = g * 128 + n;
                frag_t ba[4], bx[4];
#pragma unroll
                for (int ks = 0; ks < 4; ++ks) { ba[ks] = *(const frag_t*)(wa + (size_t)n * 128 + ks * 32 + fq * 8); bx[ks] = *(const frag_t*)(wx + (size_t)n * 128 + ks * 32 + fq * 8); }
                const float b_a = A.in[I_LBA][l * 512 + cch], b_x = A.in[I_LBX][l * 512 + cch], spl = softplusf_(-A.in[I_LLAM][l * 512 + cch]);
#pragma unroll 1
                for (int m = 0; m < 4; ++m) {
                    f32x4 ca = {0.f, 0.f, 0.f, 0.f}, cx = {0.f, 0.f, 0.f, 0.f};
#pragma unroll
                    for (int ks = 0; ks < 4; ++ks) { const frag_t af = *(const LAS frag_t*)(xc + (m * 16 + fr) * XCS + g * 128 + ks * 32 + fq * 8);
                        ca = MFMA16(af, ba[ks], ca); cx = MFMA16(af, bx[ks], cx); }
#pragma unroll
                    for (int j = 0; j < 4; ++j) { const int tk = m * 16 + fq * 4 + j;
                        const float r = sigmoidf_(ca[j] + b_a), ig = sigmoidf_(cx[j] + b_x), la = -8.f * r * spl;
                        const float om = -expm1f(la), mult = sqrtf(-expm1f(2.f * la)), xv = bf1(xc[tk * XCS + cch]);
                        lom[(size_t)(r0 + tk) * 512 + cch] = to_bf1(om); lbb[(size_t)(r0 + tk) * 512 + cch] = to_bf1(mult * ig * xv); }
                }
            }
        }
        __syncthreads();
        for (int h = 0; h < 4; ++h) k1_gla_head<128>(A, lds, l, h, r0, (bb * 4 + h) * 64 + chunk, proj, aux);
        for (int h = 0; h < 4; ++h) k1_gla_head<64>(A, lds, l, h, r0, (bb * 4 + h) * 64 + chunk, proj, aux);
        LAS bf16_t* kL = (LAS bf16_t*)lds;
        LAS bf16_t* qL = kL + 64 * P136;
        LAS float* AL = (LAS float*)(lds + 36864);
        float gcv = 0.f;
        if (tid < 256) { const int tk = tid & 63, h = tid >> 6;
            for (int s2 = 0; s2 < 64; ++s2) { const float v = sg[h * 64 + s2]; gcv += (s2 <= tk) ? v : 0.f; } }
        __syncthreads();
        if (tid < 256) sg[tid] = gcv;
        __syncthreads();
        for (int h = 0; h < 4; ++h) {
            const int ci = (bb * 4 + h) * 64 + chunk;
            bf16_t* gq = (bf16_t*)(aux + AX_GQ) + (size_t)ci * 64 * 128; const bf16_t* gk = (const bf16_t*)(aux + AX_GW) + (size_t)ci * 64 * 128;
            bf16_t* gkt = (bf16_t*)(aux + AX_GKT) + (size_t)ci * 128 * 64;
            const float glast = sg[h * 64 + 63];
#pragma unroll
            for (int e2 = 0; e2 < 2; ++e2) { const int e = tid + e2 * NTHREADS, t = e & 63, dc = (e >> 6) * 8; const float gct = sg[h * 64 + t];
                const u32x4 kr = *(const u32x4*)(gk + t * 128 + dc), qr = *(const u32x4*)(gq + t * 128 + dc);
                *(LAS u32x4*)(kL + t * P136 + dc) = kr; *(LAS u32x4*)(qL + t * P136 + dc) = qr;
                float kf[8], qf[8]; unpack8(kr, kf); unpack8(qr, qf);
                const float eg = __expf(gct), ek = __expf(glast - gct);
#pragma unroll
                for (int j = 0; j < 8; ++j) { gkt[(dc + j) * 64 + t] = to_bf1(kf[j] * ek); qf[j] *= eg; }
                *(u32x4*)(gq + t * 128 + dc) = pack8(qf); }
            if (tid == 0) ((float*)(aux + AX_GGL))[ci] = __expf(glast);
            __syncthreads();
            { bf16_t* gqk = (bf16_t*)(aux + AX_GQK) + (size_t)ci * 64 * 64; LAS float* ALh = AL + h * 64 * P68;
#pragma unroll
                for (int tt = 0; tt < 2; ++tt) { const int id = wave * 2 + tt, mi = id >> 2, nj = id & 3;
                    f32x4 ak = {0.f, 0.f, 0.f, 0.f}, aq = {0.f, 0.f, 0.f, 0.f};
                    if (nj <= mi) {
#pragma unroll
                        for (int ks = 0; ks < 4; ++ks) { const frag_t ka = *(const LAS frag_t*)(kL + (mi * 16 + fr) * P136 + ks * 32 + fq * 8), qa = *(const LAS frag_t*)(qL + (mi * 16 + fr) * P136 + ks * 32 + fq * 8),
                                kb = *(const LAS frag_t*)(kL + (nj * 16 + fr) * P136 + ks * 32 + fq * 8);
                            ak = MFMA16(ka, kb, ak); aq = MFMA16(qa, kb, aq); } }
                    const int j = nj * 16 + fr; const float gj = sg[h * 64 + j];
#pragma unroll
                    for (int r = 0; r < 4; ++r) { const int i = mi * 16 + fq * 4 + r; const float dec = __expf(fminf(sg[h * 64 + i] - gj, 0.f));
                        ALh[i * P68 + j] = (j < i) ? sb[h * 64 + i] * ak[r] * dec : 0.f;
                        gqk[i * 64 + j] = to_bf1(j <= i ? aq[r] * dec : 0.f); } }
            }
            __syncthreads();
        }
        if (wave < 4) { LAS float* ALh = AL + wave * 64 * P68;
            float T[64];
#pragma unroll
            for (int i = 0; i < 64; ++i) { int li = lane; asm volatile("" : "+v"(li)); float a0 = (li == i) ? 1.f : 0.f, a1 = 0.f;
#pragma unroll
                for (int m4 = 0; m4 < i; m4 += 4) { const f32x4 av = *(const LAS f32x4*)(ALh + i * P68 + m4);
                    a0 = fmaf(-av[0], T[m4], a0);
                    if (m4 + 1 < i) a1 = fmaf(-av[1], T[m4 + 1], a1);
                    if (m4 + 2 < i) a0 = fmaf(-av[2], T[m4 + 2], a0);
                    if (m4 + 3 < i) a1 = fmaf(-av[3], T[m4 + 3], a1); }
                T[i] = a0 + a1; }
            asm volatile("s_waitcnt lgkmcnt(0)" ::: "memory");
            LAS bf16_t* TLh = (LAS bf16_t*)ALh;
#pragma unroll
            for (int i = 0; i < 64; ++i) TLh[i * P72 + lane] = to_bf1(T[i]);
        }
        __syncthreads();
        LAS bf16_t* XT = kL; LAS bf16_t* VT = XT + 128 * P72;
        for (int h = 0; h < 4; ++h) {
            const int ci = (bb * 4 + h) * 64 + chunk;
            bf16_t* gw = (bf16_t*)(aux + AX_GW) + (size_t)ci * 64 * 128; const bf16_t* gv = (const bf16_t*)(aux + AX_GO) + (size_t)ci * 64 * 128;
            bf16_t* gut = (bf16_t*)(aux + AX_GUT) + (size_t)ci * 128 * 64;
#pragma unroll
            for (int e2 = 0; e2 < 2; ++e2) { const int e = tid + e2 * NTHREADS, t = e & 63, dc = (e >> 6) * 8; const float bt = sb[h * 64 + t], bx = bt * __expf(sg[h * 64 + t]);
                float kf[8], vf[8]; load8(gw + t * 128 + dc, kf); load8(gv + t * 128 + dc, vf);
#pragma unroll
                for (int j = 0; j < 8; ++j) { XT[(dc + j) * P72 + t] = to_bf1(kf[j] * bx); VT[(dc + j) * P72 + t] = to_bf1(vf[j] * bt); } }
            __syncthreads();
            { const LAS bf16_t* TLh = (const LAS bf16_t*)(AL + h * 64 * P68);
#pragma unroll 1
                for (int tt = 0; tt < 4; ++tt) { const int id = wave * 4 + tt, mi = id >> 3, nd = id & 7;
                    f32x4 aw = {0.f, 0.f, 0.f, 0.f}, au = {0.f, 0.f, 0.f, 0.f};
#pragma unroll
                    for (int ks = 0; ks < 2; ++ks) { const frag_t ta = *(const LAS frag_t*)(TLh + (mi * 16 + fr) * P72 + ks * 32 + fq * 8), xb = *(const LAS frag_t*)(XT + (nd * 16 + fr) * P72 + ks * 32 + fq * 8),
                            vb = *(const LAS frag_t*)(VT + (nd * 16 + fr) * P72 + ks * 32 + fq * 8);
                        aw = MFMA16(ta, xb, aw); au = MFMA16(ta, vb, au); }
#pragma unroll
                    for (int r = 0; r < 4; ++r) gw[(mi * 16 + fq * 4 + r) * 128 + nd * 16 + fr] = to_bf1(aw[r]);
                    u32x2 o; o.x = pk_bf16(au[0], au[1]); o.y = pk_bf16(au[2], au[3]);
                    *(u32x2*)(gut + (nd * 16 + fr) * 64 + mi * 16 + fq * 4) = o; }
            }
            __syncthreads();
        }
    }
}

template <bool DELTA, int DK>
__device__ __forceinline__ void k2_unit(LAS unsigned char* lds, unsigned char* aux, bf16_t* proj, int bbh) {
    constexpr int PD = DK + 8, MT = DK / 16, KS = DK / 32;
    constexpr bool HG = (DK == 128);
    const int tid = threadIdx.x, lane = tid & 63, wave = __builtin_amdgcn_readfirstlane(tid >> 6), fr = lane & 15, fq = lane >> 4;
    LAS bf16_t* sA1 = (LAS bf16_t*)lds;
    LAS bf16_t* sA2 = sA1 + 64 * PD;
    constexpr int PD2 = DELTA ? PD : P136;
    LAS bf16_t* sKT = sA2 + 64 * PD2;
    LAS bf16_t* sAT = sKT + DK * P72;
    LAS float* sGD = (LAS float*)(sAT + 64 * P72);
    LAS bf16_t* pS = (LAS bf16_t*)(sGD + 128) + (wave & 3) * (32 * PD + 32 * P72);
    LAS bf16_t* pX = pS + 32 * PD;
    const int bb = bbh >> 2, h = bbh & 3;
    const size_t ci0 = (size_t)bbh * 64;
    const bf16_t* gA1; const bf16_t* gA2; const bf16_t* gKT; const bf16_t* gAT; const float* gGD; size_t a1ld, a2ld, a1cs, a2cs;
    if (DELTA) { gA1 = (const bf16_t*)(aux + AX_GW) + ci0 * 8192; gA2 = (const bf16_t*)(aux + AX_GQ) + ci0 * 8192; a1ld = 128; a2ld = 128; a1cs = 8192; a2cs = 8192;
        gKT = (const bf16_t*)(aux + AX_GKT) + ci0 * 8192; gAT = (const bf16_t*)(aux + AX_GQK) + ci0 * 4096; gGD = (const float*)(aux + AX_GGL) + ci0; }
    else { gA1 = proj + (size_t)bb * SEQ * NPROJ + (HG ? C_BQ : C_DQ) + h * DK; gA2 = proj + (size_t)bb * SEQ * NPROJ + (HG ? C_BI : C_DV) + h * 128; a1ld = NPROJ; a2ld = NPROJ; a1cs = (size_t)64 * NPROJ; a2cs = (size_t)64 * NPROJ;
        gKT = (const bf16_t*)(aux + (HG ? AX_HKT : AX_DKT)) + ci0 * DK * 64; gAT = (const bf16_t*)(aux + (HG ? AX_HATT : AX_DATT)) + ci0 * 4096; gGD = (const float*)(aux + (HG ? AX_HGD : AX_DGD)) + ci0 * DK; }
    constexpr int N1 = 64 * DK / 8 / 256, N2 = DELTA ? N1 : 4, NK = DK * 8 / 256, NA = 2;
    u32x4 r1[N1], r2[N2], rk[NK], ra[NA]; float rg = 0.f;
    const int st = tid - 256;
#define K2_GLOAD(c_) do { if (wave >= 4) { \
        _Pragma("unroll") for (int i = 0; i < N1; ++i) { const int e = st + i * 256, r = e / (DK / 8), cc = (e % (DK / 8)) * 8; r1[i] = *(const u32x4*)(gA1 + (size_t)(c_) * a1cs + (size_t)r * a1ld + cc); } \
        _Pragma("unroll") for (int i = 0; i < N2; ++i) { const int e = st + i * 256, r = DELTA ? e / (DK / 8) : e / 16, cc = (DELTA ? e % (DK / 8) : e % 16) * 8; r2[i] = *(const u32x4*)(gA2 + (size_t)(c_) * a2cs + (size_t)r * a2ld + cc); } \
        _Pragma("unroll") for (int i = 0; i < NK; ++i) { const int e = st + i * 256; rk[i] = *(const u32x4*)(gKT + (size_t)(c_) * DK * 64 + (size_t)e * 8); } \
        _Pragma("unroll") for (int i = 0; i < NA; ++i) { const int e = st + i * 256; ra[i] = *(const u32x4*)(gAT + (size_t)(c_) * 4096 + (size_t)e * 8); } \
        if (DELTA) { if (st == 0) rg = gGD[(c_)]; } else { if (st < DK) rg = gGD[(size_t)(c_) * DK + st]; } } } while (0)
#define K2_LSTORE() do { if (wave >= 4) { \
        _Pragma("unroll") for (int i = 0; i < N1; ++i) { const int e = st + i * 256, r = e / (DK / 8), cc = (e % (DK / 8)) * 8; *(LAS u32x4*)(sA1 + r * PD + cc) = r1[i]; } \
        _Pragma("unroll") for (int i = 0; i < N2; ++i) { const int e = st + i * 256, r = DELTA ? e / (DK / 8) : e / 16, cc = (DELTA ? e % (DK / 8) : e % 16) * 8; *(LAS u32x4*)(sA2 + r * PD2 + cc) = r2[i]; } \
        _Pragma("unroll") for (int i = 0; i < NK; ++i) { const int e = st + i * 256, r = e / 8, cc = (e % 8) * 8; *(LAS u32x4*)(sKT + r * P72 + cc) = rk[i]; } \
        _Pragma("unroll") for (int i = 0; i < NA; ++i) { const int e = st + i * 256, r = e / 8, cc = (e % 8) * 8; *(LAS u32x4*)(sAT + r * P72 + cc) = ra[i]; } \
        if (DELTA) { if (st == 0) sGD[0] = rg; } else { if (st < DK) sGD[st] = rg; } } } while (0)
    f32x4 accS[MT][2];
#pragma unroll
    for (int m = 0; m < MT; ++m) { accS[m][0] = (f32x4){0.f, 0.f, 0.f, 0.f}; accS[m][1] = (f32x4){0.f, 0.f, 0.f, 0.f}; }
    const int dv0 = wave * 32;
    const bf16_t* gUT = (const bf16_t*)(aux + AX_GUT) + ci0 * 8192;
    bf16_t* gO = DELTA ? (bf16_t*)(aux + AX_GO) + ci0 * 8192 : proj + (size_t)bb * SEQ * NPROJ + (HG ? C_BI : C_DV) + h * 128;
    const size_t old = DELTA ? 128 : NPROJ, ocs = DELTA ? 8192 : (size_t)64 * NPROJ;
    u32x2 ru[4][2];
#define K2_ULOAD(c_) do { if (DELTA && wave < 4) { _Pragma("unroll") for (int m = 0; m < 4; ++m) _Pragma("unroll") for (int nt = 0; nt < 2; ++nt) \
        ru[m][nt] = *(const u32x2*)(gUT + (size_t)(c_) * 8192 + (size_t)(dv0 + nt * 16 + fr) * 64 + m * 16 + fq * 4); } } while (0)
    K2_GLOAD(0); K2_LSTORE(); K2_ULOAD(0);
    __syncthreads();
    if (wave >= 4) {
        for (int c = 0; c < 64; ++c) {
            if (c + 1 < 64) K2_GLOAD(c + 1);
            __syncthreads();
            if (c + 1 < 64) K2_LSTORE();
            __syncthreads();
        }
    } else
    for (int c = 0; c < 64; ++c) {
        {
#pragma unroll
            for (int m = 0; m < MT; ++m)
#pragma unroll
                for (int nt = 0; nt < 2; ++nt) { u32x2 o; o.x = pk_bf16(accS[m][nt][0], accS[m][nt][1]); o.y = pk_bf16(accS[m][nt][2], accS[m][nt][3]);
                    *(LAS u32x2*)(pS + (nt * 16 + fr) * PD + m * 16 + fq * 4) = o; }
            asm volatile("s_waitcnt lgkmcnt(0)" ::: "memory");
#define K2_BS(ks_, nt_) (*(const LAS frag_t*)(pS + ((nt_) * 16 + fr) * PD + (ks_) * 32 + fq * 8))
#define K2_AF(base_, pd_, m_, ks_) (*(const LAS frag_t*)((base_) + ((m_) * 16 + fr) * (pd_) + (ks_) * 32 + fq * 8))
#define SB0 __builtin_amdgcn_sched_barrier(0)
            frag_t bX[2][2];
            frag_t fa[2][4], fb[2][2];
            if (DELTA) {
                f32x4 accV[4][2];
#pragma unroll
                for (int m = 0; m < 4; ++m)
#pragma unroll
                    for (int nt = 0; nt < 2; ++nt) { accV[m][nt][0] = -bf_lo(ru[m][nt].x); accV[m][nt][1] = -bf_hi(ru[m][nt].x); accV[m][nt][2] = -bf_lo(ru[m][nt].y); accV[m][nt][3] = -bf_hi(ru[m][nt].y); }
#pragma unroll
                for (int m = 0; m < 4; ++m) fa[0][m] = K2_AF(sA1, PD, m, 0);
                fb[0][0] = K2_BS(0, 0); fb[0][1] = K2_BS(0, 1);
#pragma unroll
                for (int ks = 0; ks < KS; ++ks) { const int cu = ks & 1, nx = cu ^ 1;
                    SB0;
                    if (ks + 1 < KS) {
#pragma unroll
                        for (int m = 0; m < 4; ++m) fa[nx][m] = K2_AF(sA1, PD, m, ks + 1);
                        fb[nx][0] = K2_BS(ks + 1, 0); fb[nx][1] = K2_BS(ks + 1, 1); }
#pragma unroll
                    for (int m = 0; m < 4; ++m) { accV[m][0] = MFMA16(fa[cu][m], fb[cu][0], accV[m][0]); accV[m][1] = MFMA16(fa[cu][m], fb[cu][1], accV[m][1]); } }
                SB0;
#pragma unroll
                for (int m = 0; m < 4; ++m)
#pragma unroll
                    for (int nt = 0; nt < 2; ++nt) { u32x2 o; o.x = pk_bf16(-accV[m][nt][0], -accV[m][nt][1]); o.y = pk_bf16(-accV[m][nt][2], -accV[m][nt][3]);
                        *(LAS u32x2*)(pX + (nt * 16 + fr) * P72 + m * 16 + fq * 4) = o; }
                asm volatile("s_waitcnt lgkmcnt(0)" ::: "memory");
#pragma unroll
                for (int ks = 0; ks < 2; ++ks)
#pragma unroll
                    for (int nt = 0; nt < 2; ++nt) bX[ks][nt] = *(const LAS frag_t*)(pX + (nt * 16 + fr) * P72 + ks * 32 + fq * 8);
            } else {
#pragma unroll
                for (int ks = 0; ks < 2; ++ks)
#pragma unroll
                    for (int nt = 0; nt < 2; ++nt) { const LAS bf16_t* vp = sA2 + (ks * 32 + fq * 8) * PD2 + dv0 + nt * 16 + fr;
                        frag_t f;
#pragma unroll
                        for (int j = 0; j < 8; ++j) f[j] = (short)vp[j * PD2];
                        bX[ks][nt] = f; }
            }
            SB0;
            {
                const LAS bf16_t* sQ = DELTA ? sA2 : sA1; constexpr int PQ = DELTA ? PD2 : PD;
                f32x4 ao[4][2];
#pragma unroll
                for (int m = 0; m < 4; ++m) { ao[m][0] = (f32x4){0.f, 0.f, 0.f, 0.f}; ao[m][1] = (f32x4){0.f, 0.f, 0.f, 0.f}; }
#pragma unroll
                for (int m = 0; m < 4; ++m) fa[0][m] = K2_AF(sQ, PQ, m, 0);
                fb[0][0] = K2_BS(0, 0); fb[0][1] = K2_BS(0, 1);
#pragma unroll
                for (int ks = 0; ks < KS + 2; ++ks) { const int cu = ks & 1, nx = cu ^ 1;
                    SB0;
                    if (ks + 1 < KS) {
#pragma unroll
                        for (int m = 0; m < 4; ++m) fa[nx][m] = K2_AF(sQ, PQ, m, ks + 1);
                        fb[nx][0] = K2_BS(ks + 1, 0); fb[nx][1] = K2_BS(ks + 1, 1); }
                    else if (ks + 1 < KS + 2) {
#pragma unroll
                        for (int m = 0; m < 4; ++m) fa[nx][m] = K2_AF(sAT, P72, m, ks + 1 - KS);
                        fb[nx][0] = bX[ks + 1 - KS][0]; fb[nx][1] = bX[ks + 1 - KS][1]; }
#pragma unroll
                    for (int m = 0; m < 4; ++m) { ao[m][0] = MFMA16(fa[cu][m], fb[cu][0], ao[m][0]); ao[m][1] = MFMA16(fa[cu][m], fb[cu][1], ao[m][1]); } }
                SB0;
#pragma unroll
                for (int m = 0; m < 4; ++m) { bf16_t* op = gO + (size_t)c * ocs + (size_t)(m * 16 + fq * 4) * old + dv0 + fr;
#pragma unroll
                    for (int r = 0; r < 4; ++r) { op[(size_t)r * old] = to_bf1(ao[m][0][r]); op[(size_t)r * old + 16] = to_bf1(ao[m][1][r]); } }
            }
            SB0;
            if (DELTA && c + 1 < 64) K2_ULOAD(c + 1);
            if (DELTA) { const float gl = sGD[0];
#pragma unroll
                for (int m = 0; m < MT; ++m) { accS[m][0] *= gl; accS[m][1] *= gl; } }
            else {
#pragma unroll
                for (int m = 0; m < MT; ++m) { const f32x4 gd = *(const LAS f32x4*)(sGD + m * 16 + fq * 4); accS[m][0] *= gd; accS[m][1] *= gd; } }
            {
                constexpr int NG = 2 * MT / 4;
#pragma unroll
                for (int q = 0; q < 4; ++q) fa[0][q] = K2_AF(sKT, P72, q % MT, q / MT);
#pragma unroll
                for (int g = 0; g < NG; ++g) { const int cu = g & 1, nx = cu ^ 1;
                    SB0;
                    if (g + 1 < NG) {
#pragma unroll
                        for (int q = 0; q < 4; ++q) { const int id = (g + 1) * 4 + q; fa[nx][q] = K2_AF(sKT, P72, id % MT, id / MT); } }
#pragma unroll
                    for (int q = 0; q < 4; ++q) { const int id = g * 4 + q, m = id % MT, ks = id / MT;
                        accS[m][0] = MFMA16(fa[cu][q], bX[ks][0], accS[m][0]); accS[m][1] = MFMA16(fa[cu][q], bX[ks][1], accS[m][1]); } }
                SB0;
            }
        }
        __syncthreads();
        __syncthreads();
    }
}
#undef K2_GLOAD
#undef K2_LSTORE
#undef K2_ULOAD
#undef K2_BS
#undef K2_AF
#undef SB0
__device__ __forceinline__ void lru_unit(LAS unsigned char* lds, unsigned char* aux, int bb, int cg) {
    const int tid = threadIdx.x, ch = tid & 15, seg = tid >> 4;
    LAS float* P = (LAS float*)lds; LAS float* Hs = P + 512;
    const size_t off = ((size_t)bb * SEQ + (size_t)seg * 128) * 512 + cg * 16 + ch;
    const bf16_t* om = (const bf16_t*)(aux + AX_LOM) + off; bf16_t* lb = (bf16_t*)(aux + AX_LB) + off;
    float p = 1.f, hv = 0.f;
#pragma unroll 8
    for (int t = 0; t < 128; ++t) { const float a = 1.f - bf1(om[(size_t)t * 512]), b = bf1(lb[(size_t)t * 512]); hv = fmaf(a, hv, b); p *= a; }
    P[tid] = p; Hs[tid] = hv;
    __syncthreads();
    float carry = 0.f;
    for (int s = 0; s < seg; ++s) carry = fmaf(P[s * 16 + ch], carry, Hs[s * 16 + ch]);
    hv = carry;
#pragma unroll 8
    for (int t = 0; t < 128; ++t) { const float a = 1.f - bf1(om[(size_t)t * 512]), b = bf1(lb[(size_t)t * 512]); hv = fmaf(a, hv, b); lb[(size_t)t * 512] = to_bf1(hv); }
    __syncthreads();
}
__device__ __forceinline__ void b2_scan(const Args& A, LAS unsigned char* lds) {
    bf16_t* proj = (bf16_t*)(A.ws + WS_PROJ); unsigned char* aux = A.ws + WS_AUX;
    const int u = blockIdx.x;
    if (u < 16) k2_unit<true, 128>(lds, aux, proj, u);
    else if (u < 32) k2_unit<false, 128>(lds, aux, proj, u - 16);
    else if (u < 48) k2_unit<false, 64>(lds, aux, proj, u - 32);
    else if (u < 176) { const int r = u - 48; lru_unit(lds, aux, r >> 5, r & 31); }
}

__device__ __forceinline__ void b3_post(const Args& A, int l) {
    const int tid = threadIdx.x, lane = tid & 63, wave = __builtin_amdgcn_readfirstlane(tid >> 6), G = gridDim.x;
    bf16_t* proj = (bf16_t*)(A.ws + WS_PROJ); unsigned char* aux = A.ws + WS_AUX;
    const int cin = (lane & 15) * 8;
    float wn[3][8];
    { const float* p0 = A.in[I_GNORM] + l * 128 + cin; const float* p1 = A.in[I_HNORM] + l * 128 + cin; const float* p2 = A.in[I_DNORM] + l * 128 + cin;
#pragma unroll
        for (int j = 0; j < 8; ++j) { wn[0][j] = p0[j]; wn[1][j] = p1[j]; wn[2][j] = p2[j]; } }
    for (int row = blockIdx.x * NWAVES + wave; row < HM; row += G * NWAVES) {
        bf16_t* pr = proj + (size_t)row * NPROJ;
        float o[8], g[8], y[8];
        { const int bb = row >> 12, t = row & 4095, hh = lane >> 4; const size_t ci = (size_t)(bb * 4 + hh) * 64 + (t >> 6);
            load8((const bf16_t*)(aux + AX_GO) + (ci * 64 + (t & 63)) * 128 + cin, o); }
        load8(pr + C_AZ + lane * 8, g);
        { float ss = 0.f;
#pragma unroll
            for (int j = 0; j < 8; ++j) { o[j] *= 0.08838834764831845f; ss += o[j] * o[j]; }
            ss = row_sum16(ss); const float r = rsqrtf(ss * (1.f / 128.f) + EPS);
#pragma unroll
            for (int j = 0; j < 8; ++j) y[j] = o[j] * r * wn[0][j] * siluf_(g[j]);
            *(u32x4*)(pr + C_AZ + lane * 8) = pack8(y); }
        load8(pr + C_BI + lane * 8, o); load8(pr + C_BG + lane * 8, g);
        { float ss = 0.f;
#pragma unroll
            for (int j = 0; j < 8; ++j) { o[j] *= 0.08838834764831845f; ss += o[j] * o[j]; }
            ss = row_sum16(ss); const float r = rsqrtf(ss * (1.f / 128.f) + EPS);
#pragma unroll
            for (int j = 0; j < 8; ++j) y[j] = o[j] * r * wn[1][j] * siluf_(g[j]);
            *(u32x4*)(pr + C_BG + lane * 8) = pack8(y); }
        load8((const bf16_t*)(aux + AX_LB) + (size_t)row * 512 + lane * 8, o); load8(pr + C_CG + lane * 8, g);
#pragma unroll
        for (int j = 0; j < 8; ++j) y[j] = o[j] * gelu_tanh(g[j]);
        *(u32x4*)(pr + C_CG + lane * 8) = pack8(y);
        load8(pr + C_DV + lane * 8, o); load8(pr + C_DG + lane * 8, g);
        { float ss = 0.f;
#pragma unroll
            for (int j = 0; j < 8; ++j) { o[j] *= 0.125f; ss += o[j] * o[j]; }
            ss = row_sum16(ss); const float r = rsqrtf(ss * (1.f / 128.f) + EPS);
#pragma unroll
            for (int j = 0; j < 8; ++j) y[j] = o[j] * r * wn[2][j] * siluf_(g[j]);
            *(u32x4*)(pr + C_DG + lane * 8) = pack8(y); }
    }
}

__device__ const unsigned PAIR_W[16] = { 0x20100800u, 0xFFE07033u, 0x21110901u, 0xFFF07140u, 0x22120A02u, 0xFFFF8041u, 0x23130B03u, 0xFFFF9042u, 0x24140C04u, 0xFFFFA050u, 0x30150D05u, 0xFFFFB051u, 0x31160E06u, 0xFFFFC060u, 0x32170F07u, 0xFFFFD061u };
__device__ __forceinline__ float fmax_dpp_quad(float m) { m = fmaxf(m, dpp_f<0xB1>(m)); m = fmaxf(m, dpp_f<0x4E>(m)); return m; }
typedef float f32x2 __attribute__((ext_vector_type(2)));
typedef int i32x8 __attribute__((ext_vector_type(8)));
__device__ __forceinline__ f32x4 mfma_f4f8(const u32x4 a, const i32x8 b, const f32x4 c) {
    const i32x8 a8 = {(int)a.x, (int)a.y, (int)a.z, (int)a.w, 0, 0, 0, 0};
    return __builtin_amdgcn_mfma_scale_f32_16x16x128_f8f6f4(a8, b, c, 4  , 0  , 0, 0x7F7F7F7F, 0, 0x7F7F7F7F);
}
__device__ __forceinline__ float clamp_f8(float x) { return fminf(fmaxf(x, -440.f), 440.f); }
__device__ __forceinline__ unsigned pk4_fp8(float a, float b, float c, float d) { int p = __builtin_amdgcn_cvt_pk_fp8_f32(a, b, 0, false); p = __builtin_amdgcn_cvt_pk_fp8_f32(c, d, p, true); return (unsigned)p; }
__device__ __forceinline__ void split4_fp8(const float (&x)[4], unsigned& hi, unsigned& lo) {
    hi = pk4_fp8(x[0], x[1], x[2], x[3]);
    const f32x2 d0 = __builtin_amdgcn_cvt_pk_f32_fp8((int)hi, false), d1 = __builtin_amdgcn_cvt_pk_f32_fp8((int)hi, true);
    lo = pk4_fp8(x[0] - d0.x, x[1] - d0.y, x[2] - d1.x, x[3] - d1.y);
}
constexpr int PE_LDS_WAVE = 16384;
__device__ __forceinline__ void pe_peer(const Args& A, LAS unsigned char* lds, int l, bool last) {
    const int tid = threadIdx.x, lane = tid & 63, wave = __builtin_amdgcn_readfirstlane(tid >> 6), G = gridDim.x;
    const float NEG_INF = __uint_as_float(0xFF800000u);
    LAS unsigned* tl = (LAS unsigned*)(lds + wave * PE_LDS_WAVE);
    LAS unsigned* sets = tl + 256;
    LAS float* sck = (LAS float*)(tl + 2048);
    LAS unsigned char* hq = (LAS unsigned char*)(tl + 1280);
    LAS unsigned* cq1 = tl + 1792; LAS unsigned* cq2 = cq1 + 32;
    float* X = A.out; bf16_t* XB = (bf16_t*)(A.ws + WS_XB); float* rstd1 = (float*)(A.ws + WS_RSTD1);
    const float* SC = (const float*)(A.ws + WS_SCORES);
    const unsigned char* U = A.ws + WS_U8; const unsigned char* V = A.ws + WS_V8;
    const float* SU = (const float*)(A.ws + WS_SU); const float* SV = (const float*)(A.ws + WS_SV);
    const float* nf = A.in[I_NFFN] + l * DM; const float* nfin = A.in[I_NFIN];
    const int sub = lane & 3, gidx = lane >> 2;
    const int stride = G * NWAVES;
    const u32x2 pcw = *(const u32x2*)(PAIR_W + 2 * (lane & 7));
#define PE_S1_LOAD(n_) do { const float* sp_ = SC + (size_t)(n_) * 2048 + gidx * 128 + sub * 32; \
        _Pragma("unroll") for (int q = 0; q < 8; ++q) { const f32x4 s_ = *(const f32x4*)(sp_ + q * 4); f32x4 k_; \
            _Pragma("unroll") for (int j = 0; j < 4; ++j) k_[j] = __uint_as_float((__float_as_uint(s_[j]) & ~0x7Fu) | (unsigned)(sub * 32 + q * 4 + j)); \
            *(LAS f32x4*)(sck + q * 256 + lane * 4) = k_; } } while (0)
#define PE_S1_ITER(it_) do { f32x4 v_[8]; \
        _Pragma("unroll") for (int q = 0; q < 8; ++q) v_[q] = *(const LAS f32x4*)(sck + q * 256 + lane * 4); \
        float m_ = fmaxf(fmaxf(v_[0][0], v_[0][1]), fmaxf(v_[0][2], v_[0][3])); \
        _Pragma("unroll") for (int q = 1; q < 8; ++q) m_ = fmaxf(fmaxf(m_, fmaxf(v_[q][0], v_[q][1])), fmaxf(v_[q][2], v_[q][3])); \
        m_ = fmax_dpp_quad(m_); \
        const unsigned mb_ = __float_as_uint(m_); \
        if (sub == 0) tl[gidx * 16 + (it_)] = mb_; \
        if (((mb_ >> 5) & 3u) == (unsigned)sub) sck[((mb_ >> 2) & 7u) * 256 + lane * 4 + (mb_ & 3u)] = NEG_INF; } while (0)
#define PE_RSTD(n_, out_) do { const float* xr_ = X + (size_t)(n_) * DM + 16 * lane; float ss_ = 0.f; \
        _Pragma("unroll") for (int j = 0; j < 4; ++j) { const f32x4 a_ = *(const f32x4*)(xr_ + 4 * j); ss_ += (a_[0] * a_[0] + a_[1] * a_[1]) + (a_[2] * a_[2] + a_[3] * a_[3]); } \
        ss_ = wave_sum64(ss_); out_ = rsqrtf(ss_ * (1.f / DM) + EPS); } while (0)
#define PE_S2(rstd_, set_) do { \
        LAS unsigned* el_ = sets + (set_) * 512; LAS float* gl_ = (LAS float*)(el_ + 128); LAS float* sul_ = gl_ + 128; LAS float* svl_ = sul_ + 128; \
        const int hh = lane >> 3, slot = lane & 7; \
        float cand[7]; \
        _Pragma("unroll") for (int q = 0; q < 7; ++q) { const unsigned code = ((q < 4 ? pcw.x : pcw.y) >> (8 * (q & 3))) & 0xFFu; \
            const float a = __uint_as_float(tl[(2 * hh) * 16 + (code >> 4)] & ~0x7Fu), b = __uint_as_float(tl[(2 * hh + 1) * 16 + (code & 15u)] & ~0x7Fu); \
            cand[q] = (code != 0xFFu) ? __uint_as_float((__float_as_uint(a + b) & ~0xFFu) | code) : NEG_INF; } \
        float best[16]; \
        _Pragma("unroll") for (int it = 0; it < 16; ++it) { \
            float m = cand[0]; \
            _Pragma("unroll") for (int q = 1; q < 7; ++q) m = fmaxf(m, cand[q]); \
            m = fmax_dpp_quad(m); m = fmaxf(m, dpp_f<0x141>(m)); \
            best[it] = m; \
            _Pragma("unroll") for (int q = 0; q < 7; ++q) cand[q] = (__float_as_uint(cand[q]) == __float_as_uint(m)) ? NEG_INF : cand[q]; } \
        const float b0 = __uint_as_float(__float_as_uint(best[0]) & ~0xFFu); \
        float e[16], es = 0.f; \
        _Pragma("unroll") for (int k = 0; k < 16; ++k) { e[k] = __expf((__uint_as_float(__float_as_uint(best[k]) & ~0xFFu) - b0) * (rstd_)); es += e[k]; } \
        const float inv = 1.f / es; \
        _Pragma("unroll") for (int k = 0; k < 16; ++k) if ((k & 7) == slot) { const unsigned code = __float_as_uint(best[k]) & 0xFFu; \
            const unsigned i0 = tl[(2 * hh) * 16 + (code >> 4)] & 0x7Fu, i1 = tl[(2 * hh + 1) * 16 + (code & 15u)] & 0x7Fu, ex = i0 * 128u + i1; \
            el_[hh * 16 + k] = ex; gl_[hh * 16 + k] = e[k] * inv; sul_[hh * 16 + k] = SU[ex]; svl_[hh * 16 + k] = SV[ex]; } } while (0)
#define PE_LDSFENCE() do { __builtin_amdgcn_wave_barrier(); asm volatile("s_waitcnt lgkmcnt(0)" ::: "memory"); __builtin_amdgcn_wave_barrier(); } while (0)
    int n = blockIdx.x * NWAVES + wave;
    int cs = 0;
    if (n < MTOK) {
        float r0_; PE_RSTD(n, r0_);
        PE_S1_LOAD(n);
#pragma unroll 1
        for (int it = 0; it < 16; ++it) PE_S1_ITER(it);
        PE_LDSFENCE();
        PE_S2(r0_, 0);
        PE_LDSFENCE();
    }
    for (; n < MTOK; n += stride) {
        const int nn = n + stride; const bool hn = nn < MTOK;
        const LAS unsigned* el = sets + cs * 512; const LAS float* gl = (const LAS float*)(el + 128); const LAS float* sul = gl + 128; const LAS float* svl = sul + 128;
        { float h[16];
            const float* xr = X + (size_t)n * DM + 16 * lane; const float* wr = nf + 16 * lane;
            float ss = 0.f;
#pragma unroll
            for (int j = 0; j < 4; ++j) { const f32x4 a = *(const f32x4*)(xr + 4 * j); h[4 * j] = a[0]; h[4 * j + 1] = a[1]; h[4 * j + 2] = a[2]; h[4 * j + 3] = a[3];
                ss += (a[0] * a[0] + a[1] * a[1]) + (a[2] * a[2] + a[3] * a[3]); }
            ss = wave_sum64(ss); const float rstd2 = rsqrtf(ss * (1.f / DM) + EPS) * 16.f;
            u32x4 qh, ql;
#pragma unroll
            for (int j = 0; j < 4; ++j) { const f32x4 w = *(const f32x4*)(wr + 4 * j);
                const float x4[4] = {clamp_f8(h[4 * j] * rstd2 * w[0]), clamp_f8(h[4 * j + 1] * rstd2 * w[1]), clamp_f8(h[4 * j + 2] * rstd2 * w[2]), clamp_f8(h[4 * j + 3] * rstd2 * w[3])};
                unsigned hi, lo; split4_fp8(x4, hi, lo); qh[j] = hi; ql[j] = lo; }
            *(LAS u32x4*)(hq + 16 * lane) = qh; *(LAS u32x4*)(hq + 1024 + 16 * lane) = ql; }
        float rs_next = 0.f;
        if (hn) { PE_S1_LOAD(nn); PE_RSTD(nn, rs_next); }
        PE_LDSFENCE();
        float acc[16];
        {
            const int fq = lane >> 4, fr = lane & 15;
            const unsigned sh = 8u * (unsigned)(fr & 3);
            const unsigned M0 = (fr >> 2) == 0 ? 0xFFFFFFFFu : 0u, M1 = (fr >> 2) == 1 ? 0xFFFFFFFFu : 0u, M2 = (fr >> 2) == 2 ? 0xFFFFFFFFu : 0u, M3 = (fr >> 2) == 3 ? 0xFFFFFFFFu : 0u;
            u32x4 bufA[4], bufB[4], bufC[4], bufD[4];
            f32x4 uacc = {0.f, 0.f, 0.f, 0.f};
            f32x4 accv[4];
#pragma unroll
            for (int i = 0; i < 4; ++i) accv[i] = (f32x4){0.f, 0.f, 0.f, 0.f};
#define PE_ULOAD(buf_, s_) do { const unsigned e_ = el[((s_) >> 1) * 16 + fr]; const unsigned char* p_ = U + (size_t)e_ * (DM / 2) + fq * 16 + ((s_) & 1) * 256; \
            _Pragma("unroll") for (int jj = 0; jj < 4; ++jj) buf_[jj] = *(const u32x4*)(p_ + jj * 64); } while (0)
#define PE_VLOAD(buf_, gv_) do { const u32x2 ee_ = *(const LAS u32x2*)(el + (gv_) * 8 + 2 * fq); \
            const unsigned char* p0_ = V + (size_t)ee_.x * (DM / 2) + fr * 8; const unsigned char* p1_ = V + (size_t)ee_.y * (DM / 2) + fr * 8; \
            _Pragma("unroll") for (int blk = 0; blk < 4; ++blk) { const u32x2 a_ = *(const u32x2*)(p0_ + blk * 128), b_ = *(const u32x2*)(p1_ + blk * 128); buf_[blk] = (u32x4){a_.x, a_.y, b_.x, b_.y}; } } while (0)
#define PE_USTEP(buf_, s_, HF_) do { const LAS unsigned char* hb_ = hq + (fr & 1) * 1024 + fq * 16 + (HF_) * 512; \
            _Pragma("unroll") for (int jj = 0; jj < 4; ++jj) { const u32x4 b0_ = *(const LAS u32x4*)(hb_ + jj * 128), b1_ = *(const LAS u32x4*)(hb_ + jj * 128 + 64); \
                const i32x8 b8_ = {(int)b0_.x, (int)b0_.y, (int)b0_.z, (int)b0_.w, (int)b1_.x, (int)b1_.y, (int)b1_.z, (int)b1_.w}; uacc = mfma_f4f8(buf_[jj], b8_, uacc); } \
            if (HF_) {   \
                const int ei_ = ((s_) >> 1) * 16 + 4 * fq; \
                const f32x4 g4_ = *(const LAS f32x4*)(gl + ei_), su4_ = *(const LAS f32x4*)(sul + ei_), sv4_ = *(const LAS f32x4*)(svl + ei_); \
                float c_[4]; \
                _Pragma("unroll") for (int r = 0; r < 4; ++r) { const float t_ = uacc[r] + dpp_f<0xB1>(uacc[r]); c_[r] = clamp_f8(g4_[r] * gelu_tanh(t_ * su4_[r] * 0.0625f) * sv4_[r] * 128.f); } \
                unsigned p1_, p2_; split4_fp8(c_, p1_, p2_); \
                if (fr == 0) { cq1[ei_ >> 2] = p1_; cq2[ei_ >> 2] = p2_; } \
                uacc = (f32x4){0.f, 0.f, 0.f, 0.f}; } } while (0)
#define PE_VSTEP(buf_, gv_) do { const u32x2 cw1_ = *(const LAS u32x2*)(cq1 + (gv_) * 2), cw2_ = *(const LAS u32x2*)(cq2 + (gv_) * 2); \
            const unsigned w0_ = ((cw1_.x >> (8 * fq)) & 0xFFu) << sh, w1_ = ((cw1_.y >> (8 * fq)) & 0xFFu) << sh, x0_ = ((cw2_.x >> (8 * fq)) & 0xFFu) << sh, x1_ = ((cw2_.y >> (8 * fq)) & 0xFFu) << sh; \
            const i32x8 B1_ = {(int)(w0_ & M0), (int)(w0_ & M1), (int)(w0_ & M2), (int)(w0_ & M3), (int)(w1_ & M0), (int)(w1_ & M1), (int)(w1_ & M2), (int)(w1_ & M3)}; \
            const i32x8 B2_ = {(int)(x0_ & M0), (int)(x0_ & M1), (int)(x0_ & M2), (int)(x0_ & M3), (int)(x1_ & M0), (int)(x1_ & M1), (int)(x1_ & M2), (int)(x1_ & M3)}; \
            _Pragma("unroll") for (int blk = 0; blk < 4; ++blk) { accv[blk] = mfma_f4f8(buf_[blk], B1_, accv[blk]); accv[blk] = mfma_f4f8(buf_[blk], B2_, accv[blk]); } } while (0)
#define PE_SEL(it_) do { __builtin_amdgcn_sched_barrier(0); PE_S1_ITER(it_); __builtin_amdgcn_sched_barrier(0); } while (0)
            PE_ULOAD(bufA, 0); PE_ULOAD(bufB, 1); PE_ULOAD(bufC, 2); PE_ULOAD(bufD, 3);
#pragma unroll 1
            for (int t = 0; t < 4; ++t) { const int s = 4 * t;
                PE_SEL(s);     PE_USTEP(bufA, s, 0);     if (t < 3) PE_ULOAD(bufA, s + 4); else PE_VLOAD(bufA, 0);
                PE_SEL(s + 1); PE_USTEP(bufB, s + 1, 1); if (t < 3) PE_ULOAD(bufB, s + 5); else PE_VLOAD(bufB, 1);
                PE_SEL(s + 2); PE_USTEP(bufC, s + 2, 0); if (t < 3) PE_ULOAD(bufC, s + 6); else PE_VLOAD(bufC, 2);
                PE_SEL(s + 3); PE_USTEP(bufD, s + 3, 1); if (t < 3) PE_ULOAD(bufD, s + 7); else PE_VLOAD(bufD, 3);
            }
#pragma unroll 1
            for (int t = 0; t < 4; ++t) { const int gv = 4 * t;
                PE_VSTEP(bufA, gv);     if (t < 3) PE_VLOAD(bufA, gv + 4);
                PE_VSTEP(bufB, gv + 1); if (t < 3) PE_VLOAD(bufB, gv + 5);
                PE_VSTEP(bufC, gv + 2); if (t < 3) PE_VLOAD(bufC, gv + 6);
                PE_VSTEP(bufD, gv + 3); if (t < 3) PE_VLOAD(bufD, gv + 7);
            }
#undef PE_ULOAD
#undef PE_VLOAD
#undef PE_USTEP
#undef PE_VSTEP
#undef PE_SEL
            PE_LDSFENCE();
#pragma unroll
            for (int blk = 0; blk < 4; ++blk)
#pragma unroll
                for (int r = 0; r < 4; ++r) sck[blk * 256 + (4 * fq + r) * 16 + fr] = accv[blk][r];
            PE_LDSFENCE();
#pragma unroll
            for (int j = 0; j < 4; ++j) { const f32x4 o = *(const LAS f32x4*)(sck + 16 * lane + 4 * j); acc[4 * j] = o[0] * (1.f / 128.f); acc[4 * j + 1] = o[1] * (1.f / 128.f); acc[4 * j + 2] = o[2] * (1.f / 128.f); acc[4 * j + 3] = o[3] * (1.f / 128.f); }
        }
        { float* xr = X + (size_t)n * DM + 16 * lane;
            f32x4 a[4]; float ss = 0.f;
#pragma unroll
            for (int j = 0; j < 4; ++j) { a[j] = *(const f32x4*)(xr + 4 * j); a[j][0] += acc[4 * j]; a[j][1] += acc[4 * j + 1]; a[j][2] += acc[4 * j + 2]; a[j][3] += acc[4 * j + 3];
                ss += (a[j][0] * a[j][0] + a[j][1] * a[j][1]) + (a[j][2] * a[j][2] + a[j][3] * a[j][3]); }
            ss = wave_sum64(ss); const float rs = rsqrtf(ss * (1.f / DM) + EPS);
            if (!last) {
#pragma unroll
                for (int j = 0; j < 4; ++j) *(f32x4*)(xr + 4 * j) = a[j];
                bf16_t* bp = XB + (size_t)n * DM + 16 * lane;
                u32x4 o; o.x = pk_bf16(a[0][0], a[0][1]); o.y = pk_bf16(a[0][2], a[0][3]); o.z = pk_bf16(a[1][0], a[1][1]); o.w = pk_bf16(a[1][2], a[1][3]); *(u32x4*)bp = o;
                o.x = pk_bf16(a[2][0], a[2][1]); o.y = pk_bf16(a[2][2], a[2][3]); o.z = pk_bf16(a[3][0], a[3][1]); o.w = pk_bf16(a[3][2], a[3][3]); *(u32x4*)(bp + 8) = o;
                if (lane == 0) rstd1[n] = rs;
            } else {
#pragma unroll
                for (int j = 0; j < 4; ++j) { const f32x4 w = *(const f32x4*)(nfin + 16 * lane + 4 * j); *(f32x4*)(xr + 4 * j) = a[j] * rs * w; }
            }
        }
        PE_LDSFENCE();
        if (hn) { PE_S2(rs_next, cs ^ 1); }
        PE_LDSFENCE();
        cs ^= 1;
    }
#undef PE_S1_LOAD
#undef PE_S1_ITER
#undef PE_RSTD
#undef PE_S2
#undef PE_LDSFENCE
}

__global__ void __launch_bounds__(NTHREADS, 2) fwd_kernel(Args A) {
    extern __shared__ __attribute__((aligned(16))) unsigned char smem[];
    LAS unsigned char* lds = (LAS unsigned char*)smem;
    const int tid = threadIdx.x, G = gridDim.x;
    const int lo = A.lo, hi = A.hi;
#define IN(k) (lo <= (k) && (k) < hi)
#define BOTH(k) (IN(k) && IN((k) + 1))
    volatile LAS unsigned* misc = (volatile LAS unsigned*)(lds + LDS_MISC);
    if (tid < 16) misc[tid] = 0u;
    __syncthreads();
    XcdBarrier bar; bar.bar = (unsigned*)(A.ws + WS_BAR); bar.x = 0; bar.st = misc;
    if (hi - lo > 1) bar = xcd_barrier_post((unsigned*)(A.ws + WS_BAR), misc);
#define SEAM(k) do { if (BOTH(k)) xcd_barrier(bar); } while (0)

#ifndef PHM
#define PHM 0xFF
#endif
    if (IN(0)) { if (PHM & 1) p0_prologue(A, lds); SEAM(0); }
#define RUN_HALF(l, half) do { \
        const int ph = 1 + (l) * 12 + (half) * 5; \
        if (IN(ph + 0)) { \
            pg8::Gemm g{(const bf16_t*)(A.ws + WS_XB) + (size_t)(half) * HM * DM, (const bf16_t*)(A.ws + WS_WIN) + (size_t)(l) * NPROJP * DM, HM, NPROJP, DM, DM}; \
            pg8::StaticOrder S; S.init(HM, NPROJP, G, (int)blockIdx.x); \
            pg8::EpiProj E{(bf16_t*)(A.ws + WS_PROJ), (const float*)(A.ws + WS_RSTD1) + (half) * HM}; \
            if (PHM & 2) pg8::gemm_phase<pg8::EpiProj>(lds, g, S, E); \
            SEAM(ph + 0); \
        } \
        if (IN(ph + 1)) { if (PHM & 4) b1_prep(A, lds, (l), (half)); SEAM(ph + 1); } \
        if (IN(ph + 2)) { if (PHM & 8) b2_scan(A, lds); SEAM(ph + 2); } \
        if (IN(ph + 3)) { if (PHM & 16) b3_post(A, (l)); SEAM(ph + 3); } \
        if (IN(ph + 4)) { \
            pg8::Gemm g{(const bf16_t*)(A.ws + WS_PROJ) + C_Y, (const bf16_t*)(A.ws + WS_WOUT) + (size_t)(l) * DM * 2048, HM, DM, 2048, NPROJ}; \
            pg8::StaticOrder S; S.init(HM, DM, G, (int)blockIdx.x); \
            pg8::EpiResid E{A.out + (size_t)(half) * HM * DM, (bf16_t*)(A.ws + WS_XB) + (size_t)(half) * HM * DM}; \
            if (PHM & 32) pg8::gemm_phase<pg8::EpiResid>(lds, g, S, E); \
            SEAM(ph + 4); \
        } } while (0)
#define RUN_TAIL(l) do { \
        const int pb = 1 + (l) * 12; \
        if (IN(pb + 10)) { \
            pg8::Gemm g{(const bf16_t*)(A.ws + WS_XB), (const bf16_t*)(A.ws + WS_WEFF) + (size_t)(l) * 2048 * DM, MTOK, 2048, DM, DM}; \
            pg8::StaticOrder S; S.init(MTOK, 2048, G, (int)blockIdx.x); \
            pg8::EpiF32 E{(float*)(A.ws + WS_SCORES), 2048}; \
            convert_tables(A, (l)); \
            if (PHM & 64) pg8::gemm_phase<pg8::EpiF32>(lds, g, S, E); \
            SEAM(pb + 10); \
        } \
        if (IN(pb + 11)) { if (PHM & 128) pe_peer(A, lds, (l), (l) == NLAYER - 1); SEAM(pb + 11); } } while (0)
    RUN_HALF(0, 0); RUN_HALF(0, 1); RUN_TAIL(0);
    RUN_HALF(1, 0); RUN_HALF(1, 1); RUN_TAIL(1);
#undef RUN_HALF
#undef RUN_TAIL
#undef IN
#undef BOTH
#undef SEAM
}
constexpr int NPHASES = 1 + NLAYER * 12;

extern "C" void kernel_launch(void* const* d_in, const int* in_sizes, int n_in, void* d_out, int out_size, void* d_ws, size_t ws_size, hipStream_t stream) {
    static int grid = 0;
    if (grid == 0) {
        if (n_in != 26 || out_size != MTOK * DM || ws_size < WS_END) { fprintf(stderr, "kernel_launch: unexpected shapes (n_in %d out %d ws %zu need %zu)\n", n_in, out_size, ws_size, (size_t)WS_END); grid = -1; return; }
        int dev = 0, cus = 0;
        if (hipGetDevice(&dev) != hipSuccess || hipDeviceGetAttribute(&cus, hipDeviceAttributeMultiprocessorCount, dev) != hipSuccess) { grid = -1; return; }
        if (hipFuncSetAttribute((const void*)fwd_kernel, hipFuncAttributeMaxDynamicSharedMemorySize, LDS_BYTES) != hipSuccess) { fprintf(stderr, "kernel_launch: hipFuncSetAttribute failed\n"); grid = -1; return; }
        int per_cu = 0;
        if (hipOccupancyMaxActiveBlocksPerMultiprocessor(&per_cu, (const void*)fwd_kernel, NTHREADS, LDS_BYTES) != hipSuccess || per_cu < 1) { fprintf(stderr, "kernel_launch: occupancy query says %d\n", per_cu); (void)hipGetLastError(); }
        grid = cus;
    }
    if (grid < 0) return;
    (void)hipMemsetAsync((char*)d_ws + WS_BAR, 0, 16384, stream);
    Args a{};
    for (int i = 0; i < 26; ++i) a.in[i] = (const float*)d_in[i];
    a.out = (float*)d_out; a.ws = (unsigned char*)d_ws;
#if MK_N_LAUNCHES == 1
    a.lo = 0; a.hi = NPHASES;
    hipLaunchKernelGGL(fwd_kernel, dim3(grid), dim3(NTHREADS), LDS_BYTES, stream, a);
#else
    for (int p = 0; p < NPHASES; ++p) { a.lo = p; a.hi = p + 1; hipLaunchKernelGGL(fwd_kernel, dim3(grid), dim3(NTHREADS), LDS_BYTES, stream, a); }
#endif
}
```
